# Optimizing an MI355X kernel written in HIP

```python
import jax, jax.numpy as jnp
from jax import lax
import numpy as np

D_MODEL = 1024
BATCH = 4
SEQ = 8192
DEPTH = 2

HEAD_DIM = 64
BRANCH_WIDTH = 256
N_HEADS_A = 4
IDX_HEADS = 4
IDX_DIM = 32
TOPK_MAX = 256
N_GROUPS_B = 4
GROUP_DIM_B = 64
CHUNK = 128
N_HEADS_C = 4
CONV_WIDTH = 3
Q_BLOCK = 128
ROPE_THETA = 10000.0
N_BRANCH = 4
N_EXPERT_GROUPS = 4
EXPERTS_PER_GROUP = 8
N_EXPERTS = N_EXPERT_GROUPS * EXPERTS_PER_GROUP
TOPK_IN_GROUP = 2
D_EXPERT = 256
MOE_BLOCK = 128
EPS = 1e-6

SPLIT_SIZES = (BRANCH_WIDTH, BRANCH_WIDTH, BRANCH_WIDTH,
               IDX_HEADS * IDX_DIM, IDX_DIM, IDX_HEADS,
               BRANCH_WIDTH, BRANCH_WIDTH,
               BRANCH_WIDTH, BRANCH_WIDTH, BRANCH_WIDTH,
               BRANCH_WIDTH, BRANCH_WIDTH, BRANCH_WIDTH,
               N_BRANCH * D_MODEL)
W_IN_COLS = sum(SPLIT_SIZES)

kernel_name = 'hybrid_gated_mixer_hmoe'


def rmsnorm(x, g):
    xf = x.astype(jnp.float32)
    y = xf * lax.rsqrt(jnp.mean(xf * xf, axis=-1, keepdims=True) + EPS)
    return (y * g.astype(jnp.float32)).astype(x.dtype)


def rope_tables(positions, dim):
    inv = ROPE_THETA ** (-jnp.arange(0, dim, 2, dtype=jnp.float32) / dim)
    ang = positions.astype(jnp.float32)[..., None] * inv
    return jnp.cos(ang)[:, :, None, :], jnp.sin(ang)[:, :, None, :]


def apply_rope(x, cos, sin):
    xf = x.astype(jnp.float32)
    x1, x2 = jnp.split(xf, 2, axis=-1)
    out = jnp.concatenate([x1 * cos - x2 * sin, x2 * cos + x1 * sin], axis=-1)
    return out.astype(x.dtype)


def to_blocks(a, nb):
    return jnp.moveaxis(a.reshape(a.shape[0], nb, Q_BLOCK, *a.shape[2:]), 1, 0)


def dsa_attention(q, k, v, iq, ik, iw):
    B, S, H, Dh = q.shape
    nb = S // Q_BLOCK
    topk = min(TOPK_MAX, S // 4)
    scale = Dh ** -0.5
    key_pos = jnp.arange(S)

    def block(args):
        qb, iqb, iwb, blk = args
        tq = blk * Q_BLOCK + jnp.arange(Q_BLOCK)
        causal = key_pos[None, :] <= tq[:, None]
        rel = jax.nn.relu(jnp.einsum('bqhd,bsd->bqhs', iqb, ik))
        score = jnp.einsum('bqh,bqhs->bqs', iwb, rel).astype(jnp.float32)
        score = jnp.where(causal[None], score, -jnp.inf)
        _, idx = lax.top_k(score, topk)
        valid = idx <= tq[None, :, None]
        k_sel = jax.vmap(lambda kb, ib: kb[ib])(k, idx)
        v_sel = jax.vmap(lambda vb, ib: vb[ib])(v, idx)
        logits = jnp.einsum('bqhd,bqkhd->bhqk', qb, k_sel).astype(jnp.float32) * scale
        logits = jnp.where(valid[:, None], logits, -jnp.inf)
        p = jax.nn.softmax(logits, axis=-1).astype(v.dtype)
        return jnp.einsum('bhqk,bqkhd->bqhd', p, v_sel)

    out = lax.map(block, (to_blocks(q, nb), to_blocks(iq, nb), to_blocks(iw, nb),
                          jnp.arange(nb)))
    return jnp.moveaxis(out, 0, 1).reshape(B, S, H * Dh)


def chunked_sgu(u, v, ln_g, ln_b, w_s, b_s):
    B, S, W = v.shape
    nc = S // CHUNK
    u = jax.nn.gelu(u)
    v = jax.nn.gelu(v)
    vf = v.astype(jnp.float32)
    mu = jnp.mean(vf, axis=-1, keepdims=True)
    var = jnp.mean(jnp.square(vf - mu), axis=-1, keepdims=True)
    vn = ((vf - mu) * lax.rsqrt(var + EPS) * ln_g + ln_b).astype(v.dtype)
    vn = vn.reshape(B, nc, CHUNK, N_GROUPS_B, GROUP_DIM_B)
    tril = jnp.tril(jnp.ones((CHUNK, CHUNK), dtype=w_s.dtype))
    mixed = jnp.einsum('gts,bcsgd->bctgd', w_s * tril, vn) + b_s.T[:, :, None]
    return u * mixed.reshape(B, S, W)


def stick_breaking_attention(q, k, v):
    B, S, H, Dh = q.shape
    nb = S // Q_BLOCK
    scale = Dh ** -0.5
    key_pos = jnp.arange(S)

    def block(args):
        qb, blk = args
        tq = blk * Q_BLOCK + jnp.arange(Q_BLOCK)
        strict = key_pos[None, :] < tq[:, None]
        z = jnp.einsum('bqhd,bshd->bhqs', qb, k).astype(jnp.float32) * scale
        log_beta = jax.nn.log_sigmoid(z)
        log_keep = jnp.where(strict, jax.nn.log_sigmoid(-z), 0.0)
        later = lax.cumsum(log_keep, axis=3, reverse=True) - log_keep
        a = jnp.where(strict, jnp.exp(log_beta + later), 0.0).astype(v.dtype)
        return jnp.einsum('bhqs,bshd->bqhd', a, v)

    out = lax.map(block, (to_blocks(q, nb), jnp.arange(nb)))
    return jnp.moveaxis(out, 0, 1).reshape(B, S, H * Dh)


def short_gated_conv(b_gate, c_gate, xin, conv_w):
    S = xin.shape[1]
    z = c_gate * xin
    zp = jnp.pad(z, ((0, 0), (CONV_WIDTH - 1, 0), (0, 0)))
    y = conv_w[0] * zp[:, 0:S]
    for tap in range(1, CONV_WIDTH):
        y = y + conv_w[tap] * zp[:, tap:tap + S]
    return b_gate * y


def token_mixers(h, cos_a, sin_a, cos_i, sin_i, w_in, ln_g, ln_b, w_s, b_s, conv_w,
                 w_branch, w_out):
    B, S, _ = h.shape
    proj = h @ w_in
    offsets = [int(o) for o in np.cumsum(SPLIT_SIZES)[:-1]]
    (qa, ka, va, iq, ik, iw, ub, vb, qc, kc, vc, bd, cd, xd,
     gate_logits) = jnp.split(proj, offsets, axis=-1)

    qa = apply_rope(qa.reshape(B, S, N_HEADS_A, HEAD_DIM), cos_a, sin_a)
    ka = apply_rope(ka.reshape(B, S, N_HEADS_A, HEAD_DIM), cos_a, sin_a)
    va = va.reshape(B, S, N_HEADS_A, HEAD_DIM)
    iq = apply_rope(iq.reshape(B, S, IDX_HEADS, IDX_DIM), cos_i, sin_i)
    ik = apply_rope(ik[:, :, None, :], cos_i, sin_i)[:, :, 0]
    y_a = dsa_attention(qa, ka, va, iq, ik, iw)

    y_b = chunked_sgu(ub, vb, ln_g, ln_b, w_s, b_s)

    y_c = stick_breaking_attention(qc.reshape(B, S, N_HEADS_C, HEAD_DIM),
                                   kc.reshape(B, S, N_HEADS_C, HEAD_DIM),
                                   vc.reshape(B, S, N_HEADS_C, HEAD_DIM))

    y_d = short_gated_conv(bd, cd, xd, conv_w)

    gates = jax.nn.sigmoid(gate_logits.astype(jnp.float32)).astype(h.dtype)
    gates = gates.reshape(B, S, N_BRANCH, D_MODEL)
    branches = (y_a, y_b, y_c, y_d)
    merged = gates[:, :, 0] * (branches[0] @ w_branch[0])
    for n in range(1, N_BRANCH):
        merged = merged + gates[:, :, n] * (branches[n] @ w_branch[n])
    return merged @ w_out


def hierarchical_moe(h, w_rg, b_rg, w_re, b_re, w_g, w_u, w_d):
    B, S, D = h.shape
    hf = h.astype(jnp.float32)
    p_grp = jax.nn.softmax(hf @ w_rg.astype(jnp.float32) + b_rg, axis=-1)
    grp_p, grp_idx = lax.top_k(p_grp, 1)
    exp_logits = (hf @ w_re.astype(jnp.float32) + b_re).reshape(
        B, S, N_EXPERT_GROUPS, EXPERTS_PER_GROUP)
    sel = jax.nn.one_hot(grp_idx[..., 0], N_EXPERT_GROUPS, dtype=jnp.float32)
    in_grp = jnp.einsum('bsg,bsge->bse', sel, exp_logits)
    top_l, top_j = lax.top_k(in_grp, TOPK_IN_GROUP)
    weights = grp_p * jax.nn.softmax(top_l, axis=-1)
    eid = grp_idx * EXPERTS_PER_GROUP + top_j
    combine = jnp.sum(jax.nn.one_hot(eid, N_EXPERTS, dtype=jnp.float32) * weights[..., None],
                      axis=2).astype(h.dtype)
    n_tok = B * S
    tok = h.reshape(n_tok // MOE_BLOCK, MOE_BLOCK, D)
    comb = combine.reshape(n_tok // MOE_BLOCK, MOE_BLOCK, N_EXPERTS)

    def block(args):
        tb, cb = args
        a = jnp.einsum('td,edf->tef', tb, w_g)
        u = jnp.einsum('td,edf->tef', tb, w_u)
        hh = jax.nn.silu(a) * u * cb[:, :, None]
        return jnp.einsum('tef,efd->td', hh, w_d)

    return lax.map(block, (tok, comb)).reshape(B, S, D)


def setup_inputs(seed: int = 0) -> dict:
    key = jax.random.key(seed)
    ks = jax.random.split(key, 19)

    def nrm(k, shape, fan):
        return jax.random.normal(k, shape, jnp.float32) * fan ** -0.5

    def noise(k, shape, s):
        return jax.random.normal(k, shape, jnp.float32) * s

    return {
        'x': jax.random.normal(ks[0], (BATCH, SEQ, D_MODEL), jnp.float32),
        'positions': jnp.broadcast_to(jnp.arange(SEQ, dtype=jnp.int32), (BATCH, SEQ)),
        'norm1_g': 1.0 + noise(ks[1], (DEPTH, D_MODEL), 0.02),
        'w_in': nrm(ks[2], (DEPTH, D_MODEL, W_IN_COLS), D_MODEL),
        'sgu_ln_g': 1.0 + noise(ks[3], (DEPTH, BRANCH_WIDTH), 0.02),
        'sgu_ln_b': noise(ks[4], (DEPTH, BRANCH_WIDTH), 0.02),
        'w_spatial': nrm(ks[5], (DEPTH, N_GROUPS_B, CHUNK, CHUNK), CHUNK),
        'b_spatial': 1.0 + noise(ks[6], (DEPTH, N_GROUPS_B, CHUNK), 0.1),
        'conv_w': nrm(ks[7], (DEPTH, CONV_WIDTH, BRANCH_WIDTH), CONV_WIDTH),
        'w_branch': nrm(ks[8], (DEPTH, N_BRANCH, BRANCH_WIDTH, D_MODEL), BRANCH_WIDTH),
        'w_out': nrm(ks[9], (DEPTH, D_MODEL, D_MODEL), D_MODEL),
        'norm2_g': 1.0 + noise(ks[10], (DEPTH, D_MODEL), 0.02),
        'w_router_group': nrm(ks[11], (DEPTH, D_MODEL, N_EXPERT_GROUPS), D_MODEL),
        'b_router_group': noise(ks[12], (DEPTH, N_EXPERT_GROUPS), 0.01),
        'w_router_expert': nrm(ks[13], (DEPTH, D_MODEL, N_EXPERTS), D_MODEL),
        'b_router_expert': noise(ks[14], (DEPTH, N_EXPERTS), 0.01),
        'w_exp_gate': nrm(ks[15], (DEPTH, N_EXPERTS, D_MODEL, D_EXPERT), D_MODEL),
        'w_exp_up': nrm(ks[16], (DEPTH, N_EXPERTS, D_MODEL, D_EXPERT), D_MODEL),
        'w_exp_down': nrm(ks[17], (DEPTH, N_EXPERTS, D_EXPERT, D_MODEL), D_EXPERT),
        'norm_f_g': 1.0 + noise(ks[18], (D_MODEL,), 0.02),
    }


def reference(x, positions, norm1_g, w_in, sgu_ln_g, sgu_ln_b, w_spatial, b_spatial, conv_w,
              w_branch, w_out, norm2_g, w_router_group, b_router_group, w_router_expert,
              b_router_expert, w_exp_gate, w_exp_up, w_exp_down, norm_f_g):
    cos_a, sin_a = rope_tables(positions, HEAD_DIM)
    cos_i, sin_i = rope_tables(positions, IDX_DIM)
    for l in range(DEPTH):
        h = rmsnorm(x, norm1_g[l])
        x = x + token_mixers(h, cos_a, sin_a, cos_i, sin_i, w_in[l], sgu_ln_g[l], sgu_ln_b[l],
                             w_spatial[l], b_spatial[l], conv_w[l], w_branch[l], w_out[l])
        h = rmsnorm(x, norm2_g[l])
        x = x + hierarchical_moe(h, w_router_group[l], b_router_group[l], w_router_expert[l],
                                 b_router_expert[l], w_exp_gate[l], w_exp_up[l], w_exp_down[l])
    return rmsnorm(x, norm_f_g)
```

```cpp
#include <hip/hip_runtime.h>
#include <cstdio>
#include <cstdint>
#define GAS __attribute__((address_space(1)))
#define LAS __attribute__((address_space(3)))
namespace pg8 {
#define PG8_LAS __attribute__((address_space(3)))
typedef unsigned short bf16_t;
typedef short bf16x8 __attribute__((ext_vector_type(8)));
typedef float f32x4 __attribute__((ext_vector_type(4)));
typedef unsigned u32x4 __attribute__((ext_vector_type(4)));
constexpr int BM = 256, BK = 64, HALF = 128, HTB = HALF * BK * 2  , STAGE_BYTES = 8 * HTB, NXCD = 8, WGM = 8;

__host__ __device__ __forceinline__ int lds_byte(int r, int c) { const int st = (r >> 4) * 2 + (c >> 5), rr = r & 15, cc = c & 31, ob = rr * 64 + cc * 2; return st * 1024 + (ob ^ (((ob >> 9) & 1) << 5)); }
__host__ __device__ __forceinline__ void stage_rc(int b, int& R, int& C) { const int st = b / 1024, sb = b % 1024, swz = sb ^ (((sb >> 9) & 1) << 5); R = (st >> 1) * 16 + swz / 64; C = (st & 1) * 32 + (swz % 64) / 2; }
__host__ __device__ __forceinline__ int perm32(int rho) { const int n = rho >> 4, i = rho & 15; return 8 * (i >> 2) + 4 * n + (i & 3); }

struct Unit { int pm, pn; };
struct Gemm { const bf16_t* A; const bf16_t* Bt; int M, N, K; };

struct StaticOrder {
    int nM, nN, nwg, G, c;
    __host__ __device__ void init(int M, int N, int G_, int c_) { nM = M / BM; nN = N / BM; nwg = nM * nN; G = G_; c = c_; }
    __host__ __device__ bool next(int i, Unit& u) const {
        const long L = (long)i * G + c; if (L >= nwg) return false;
        int wgid = (int)L; { const int q = nwg / NXCD, r = nwg % NXCD, xcd = wgid % NXCD, off = wgid / NXCD; wgid = (xcd < r ? xcd * (q + 1) : r * (q + 1) + (xcd - r) * q) + off; }
        const int nig = WGM * nN, gid = wgid / nig, fm = gid * WGM, gsz = (nM - fm) < WGM ? (nM - fm) : WGM;
        u.pm = fm + ((wgid % nig) % gsz); u.pn = (wgid % nig) / gsz; return true;
    }
    __device__ __forceinline__ void a_ready(const Unit&) const {}
    __device__ __forceinline__ void done(const Unit&) const {}
};

typedef __bf16 bf16x2_native __attribute__((ext_vector_type(2)));
__device__ __forceinline__ unsigned cvt_pk_bf16(float lo, float hi) { const float __attribute__((ext_vector_type(2))) v = {lo, hi}; return __builtin_bit_cast(unsigned, __builtin_convertvector(v, bf16x2_native)); }
typedef float f32x2 __attribute__((ext_vector_type(2)));
template <class Epi, class Sched, bool ALIGN_EPI = false, bool SP2 = false, bool GATHER = false>
__device__ __forceinline__ void gemm_phase(PG8_LAS unsigned char* lds, const Gemm g, const Sched& S, const Epi& E, int wid_in, const PG8_LAS int* rowtab = nullptr) {
    static_assert(!GATHER || SP2, "GATHER is implemented for the SP2 loop only");
    int lane_; asm volatile("v_mbcnt_lo_u32_b32 %0, -1, 0\n\tv_mbcnt_hi_u32_b32 %0, -1, %0" : "=v"(lane_)); int wid_ = wid_in; asm volatile("" : "+s"(wid_));
    const int wid = wid_, lane = lane_, tid = wid * 64 + lane, wr = wid >> 2, wc = wid & 3, fr = lane & 15, fq = lane >> 4;
    const int K = g.K, nt = K / BK;
    unsigned voffA[2], voffB[2];
#pragma unroll
    for (int i = 0; i < 2; ++i) { int R, C; stage_rc(tid * 16 + i * 8192, R, C); const int Rb = Epi::PERM ? ((R & ~31) + perm32(R & 31)) : R;
        voffA[i] = (unsigned)(R * K + C) * 2u; voffB[i] = (unsigned)(Rb * K + C) * 2u; }
    const size_t kstep = (size_t)(BK * 2);
    const size_t hstep = (size_t)HALF * K * 2;
    const size_t tstep = 2 * hstep;
    const unsigned ldsw = (unsigned)wid * 1024u;
    const int aoff = lds_byte(wr * 64 + fr, fq * 8), boff = lds_byte(wc * 32 + fr, fq * 8);
#define PG8_SA(b, h) (((b) * 2 + (h)) * HTB)
#define PG8_SB(b, h) ((4 + (b) * 2 + (h)) * HTB)
#define PG8_STAGE(bufoff, gbase, voff) do { _Pragma("unroll") for (int _i = 0; _i < 2; ++_i) \
        __builtin_amdgcn_global_load_lds((const unsigned*)((const char*)(gbase) + (voff)[_i]), (PG8_LAS unsigned*)(lds + (bufoff) + ldsw + _i * 8192), 16, 0, 0); } while (0)
#define PG8_STAGE_A(bufoff, gbase, h, goff) do { if constexpr (GATHER) PG8_STAGE(bufoff, gbase, (goff)[h]); else PG8_STAGE(bufoff, (gbase) + (h) * hstep, voffA); } while (0)
#define PG8_ROWS(slot, o) do { _Pragma("unroll") for (int _h = 0; _h < 2; ++_h) _Pragma("unroll") for (int _i = 0; _i < 2; ++_i) { const unsigned _R = voffA[_i] / (2u * (unsigned)K), _c2 = voffA[_i] - _R * (2u * (unsigned)K); \
        (o)[_h][_i] = (unsigned)rowtab[(slot) * 256 + _h * 128 + (int)_R] * (2u * (unsigned)K) + _c2; } } while (0)
#define PG8_LDA(dst, b, h) do { _Pragma("unroll") for (int m = 0; m < 4; ++m) _Pragma("unroll") for (int k = 0; k < 2; ++k) dst[m][k] = *(const PG8_LAS bf16x8*)(lds + PG8_SA(b, h) + aoff + m * 2048 + k * 1024); } while (0)
#define PG8_LDB(dst, b, h) do { _Pragma("unroll") for (int n = 0; n < 2; ++n) _Pragma("unroll") for (int k = 0; k < 2; ++k) dst[n][k] = *(const PG8_LAS bf16x8*)(lds + PG8_SB(b, h) + boff + n * 2048 + k * 1024); } while (0)
#define PG8_MMA(ai, bj, At, Bt) do { __builtin_amdgcn_s_setprio(1); _Pragma("unroll") for (int m = 0; m < 4; ++m) _Pragma("unroll") for (int n = 0; n < 2; ++n) _Pragma("unroll") for (int k = 0; k < 2; ++k) \
        acc[ai][bj][m][n] = __builtin_amdgcn_mfma_f32_16x16x32_bf16(Bt[n][k], At[m][k], acc[ai][bj][m][n], 0, 0, 0); __builtin_amdgcn_s_setprio(0); } while (0)
#define PG8_WAIT_V(n) asm volatile("s_waitcnt vmcnt(" #n ")" ::: "memory")
#define PG8_WAIT_L(n) asm volatile("s_waitcnt lgkmcnt(" #n ")" ::: "memory")
#define PG8_BAR __builtin_amdgcn_s_barrier()
#define PG8_SCHED __builtin_amdgcn_sched_barrier(0)
    Unit cur, nxt; int ui = 0;
    if (!S.next(0, cur)) return;
    f32x4 acc[2][2][4][2];
#pragma unroll
    for (int a = 0; a < 2; ++a)
#pragma unroll
        for (int b = 0; b < 2; ++b)
#pragma unroll
            for (int m = 0; m < 4; ++m)
#pragma unroll
                for (int n = 0; n < 2; ++n) acc[a][b][m][n] = (f32x4){0.f, 0.f, 0.f, 0.f};
    bf16x8 At[4][2], B0[2][2], B1[2][2];
    const char* cA = GATHER ? (const char*)g.A : (const char*)g.A + (size_t)cur.pm * tstep; const char* cB = (const char*)g.Bt + (size_t)cur.pn * tstep;
    unsigned gC[2][2] = {{0u, 0u}, {0u, 0u}};
    if constexpr (GATHER) PG8_ROWS(0, gC);
    S.a_ready(cur);
    if constexpr (SP2) {
        PG8_STAGE(PG8_SB(0, 0), cB, voffB); PG8_STAGE(PG8_SB(0, 1), cB + hstep, voffB); PG8_STAGE_A(PG8_SA(0, 0), cA, 0, gC); PG8_STAGE_A(PG8_SA(0, 1), cA, 1, gC);
        if (wr == 1) PG8_BAR;
        PG8_WAIT_V(2); PG8_BAR;
        PG8_STAGE(PG8_SB(1, 0), cB + kstep, voffB); PG8_STAGE_A(PG8_SA(1, 0), cA + kstep, 0, gC); PG8_STAGE(PG8_SB(1, 1), cB + hstep + kstep, voffB);
        PG8_WAIT_V(6); PG8_BAR;
    } else {
        PG8_STAGE(PG8_SB(0, 0), cB, voffB); PG8_STAGE(PG8_SA(0, 0), cA, voffA); PG8_STAGE(PG8_SB(0, 1), cB + hstep, voffB); PG8_STAGE(PG8_SA(0, 1), cA + hstep, voffA);
        if (wr == 1) PG8_BAR;
        PG8_WAIT_V(4); PG8_BAR;
        PG8_STAGE(PG8_SB(1, 0), cB + kstep, voffB); PG8_STAGE(PG8_SA(1, 0), cA + kstep, voffA); PG8_STAGE(PG8_SB(1, 1), cB + hstep + kstep, voffB);
        PG8_WAIT_V(6); PG8_BAR;
    }
    for (;;) {
        const bool has_next = S.next(ui + 1, nxt);
        const char* nA = (has_next && !GATHER) ? (const char*)g.A + (size_t)nxt.pm * tstep : cA; const char* nB = has_next ? (const char*)g.Bt + (size_t)nxt.pn * tstep : cB;
#pragma unroll 1
        for (int t = 0; t < nt; t += 2) {
            const bool last = (t == nt - 2);
            const char* a1 = cA + (size_t)(t + 1) * kstep;
            const char* a2 = last ? nA : cA + (size_t)(t + 2) * kstep; const char* b2 = last ? nB : cB + (size_t)(t + 2) * kstep;
            const char* a3 = a2 + kstep; const char* b3 = b2 + kstep;
            if (last && has_next) S.a_ready(nxt);
            unsigned gS[2][2];
#pragma unroll
            for (int _h = 0; _h < 2; ++_h)
#pragma unroll
                for (int _i = 0; _i < 2; ++_i) gS[_h][_i] = gC[_h][_i];
            if constexpr (GATHER) { if (last && has_next) PG8_ROWS(ui + 1, gS); }
            if constexpr (SP2) {
            PG8_LDB(B0, 0, 0); PG8_LDB(B1, 0, 1); PG8_SCHED; PG8_LDA(At, 0, 0); PG8_STAGE_A(PG8_SA(1, 1), a1, 1, gC);
            PG8_WAIT_V(8); PG8_WAIT_L(0); PG8_BAR; PG8_MMA(0, 0, At, B0); PG8_MMA(0, 1, At, B1); PG8_BAR; PG8_SCHED;
            PG8_LDA(At, 0, 1); PG8_STAGE(PG8_SB(0, 0), b2, voffB); PG8_STAGE(PG8_SB(0, 1), b2 + hstep, voffB); PG8_STAGE_A(PG8_SA(0, 0), a2, 0, gS);
            PG8_WAIT_V(8); PG8_WAIT_L(0); PG8_BAR; PG8_MMA(1, 0, At, B0); PG8_MMA(1, 1, At, B1); PG8_BAR; PG8_SCHED;
            PG8_LDB(B0, 1, 0); PG8_LDB(B1, 1, 1); PG8_SCHED; PG8_LDA(At, 1, 0); PG8_STAGE_A(PG8_SA(0, 1), a2, 1, gS);
            PG8_WAIT_V(8); PG8_WAIT_L(0); PG8_BAR; PG8_MMA(0, 0, At, B0); PG8_MMA(0, 1, At, B1); PG8_BAR; PG8_SCHED;
            PG8_LDA(At, 1, 1); PG8_STAGE(PG8_SB(1, 0), b3, voffB); PG8_STAGE(PG8_SB(1, 1), b3 + hstep, voffB); PG8_STAGE_A(PG8_SA(1, 0), a3, 0, gS);
            PG8_WAIT_V(8); PG8_WAIT_L(0); PG8_BAR; PG8_MMA(1, 0, At, B0); PG8_MMA(1, 1, At, B1); PG8_BAR; PG8_SCHED;
            } else {
            PG8_LDB(B0, 0, 0); PG8_SCHED; PG8_LDA(At, 0, 0); PG8_STAGE(PG8_SA(1, 1), a1 + hstep, voffA);
            PG8_WAIT_L(8); PG8_BAR; PG8_WAIT_L(0); PG8_MMA(0, 0, At, B0); PG8_BAR; PG8_SCHED;
            PG8_LDB(B1, 0, 1); PG8_STAGE(PG8_SB(0, 0), b2, voffB);
            PG8_BAR; PG8_WAIT_L(0); PG8_MMA(0, 1, At, B1); PG8_BAR;
            PG8_LDA(At, 0, 1); PG8_STAGE(PG8_SA(0, 0), a2, voffA);
            PG8_BAR; PG8_WAIT_L(0); PG8_MMA(1, 0, At, B0); PG8_BAR; PG8_SCHED;
            PG8_STAGE(PG8_SB(0, 1), b2 + hstep, voffB);
            PG8_WAIT_V(6); PG8_BAR; PG8_MMA(1, 1, At, B1); PG8_BAR;
            PG8_LDB(B0, 1, 0); PG8_SCHED; PG8_LDA(At, 1, 0); PG8_STAGE(PG8_SA(0, 1), a2 + hstep, voffA);
            PG8_WAIT_L(8); PG8_BAR; PG8_WAIT_L(0); PG8_MMA(0, 0, At, B0); PG8_BAR; PG8_SCHED;
            PG8_LDB(B1, 1, 1); PG8_STAGE(PG8_SB(1, 0), b3, voffB);
            PG8_BAR; PG8_WAIT_L(0); PG8_MMA(0, 1, At, B1); PG8_BAR;
            PG8_LDA(At, 1, 1); PG8_STAGE(PG8_SA(1, 0), a3, voffA);
            PG8_BAR; PG8_WAIT_L(0); PG8_MMA(1, 0, At, B0); PG8_BAR; PG8_SCHED;
            PG8_STAGE(PG8_SB(1, 1), b3 + hstep, voffB);
            PG8_WAIT_V(6); PG8_BAR; PG8_MMA(1, 1, At, B1); PG8_BAR;
            }
        }
        if constexpr (ALIGN_EPI) { if (wr == 0) PG8_BAR; }
        if constexpr (!Epi::AFTER_DRAIN) { E(acc, cur, wr, wc, fr, fq); S.done(cur); }
        if (!has_next) break;
#pragma unroll
        for (int a = 0; a < 2; ++a)
#pragma unroll
            for (int b = 0; b < 2; ++b)
#pragma unroll
                for (int m = 0; m < 4; ++m)
#pragma unroll
                    for (int n = 0; n < 2; ++n) acc[a][b][m][n] = (f32x4){0.f, 0.f, 0.f, 0.f};
        cur = nxt; cA = nA; cB = nB; ++ui;
        if constexpr (GATHER) PG8_ROWS(ui, gC);
        if constexpr (ALIGN_EPI) { if (wr == 1) PG8_BAR; }
    }
    PG8_WAIT_V(0);
    if constexpr (!ALIGN_EPI) { if (wr == 0) PG8_BAR; }
    PG8_BAR;
    if constexpr (Epi::AFTER_DRAIN) { E.fused(acc, cur, wr, wc, fr, fq, lds, wid, lane); S.done(cur); }
#undef PG8_SA
#undef PG8_SB
#undef PG8_STAGE
#undef PG8_LDA
#undef PG8_STAGE_A
#undef PG8_ROWS
#undef PG8_LDB
#undef PG8_MMA
#undef PG8_WAIT_V
#undef PG8_WAIT_L
#undef PG8_BAR
#undef PG8_SCHED
}
}
#define XB_TMO      128
#define XB_XCNT(j)  (256  + 64 * (j))
#define XB_XSUB(j)  (1280 + 64 * (j))
#define XB_XGEN(j)  (2304 + 64 * (j))
#define XB_TOP      3328
#define XB_TOPGEN   3392
#define XCD_BAR_WORDS 3456
#define XB_SPIN_CAP (1u << 18)

__device__ __forceinline__ unsigned xb_ld(unsigned* p)              { return __hip_atomic_load(p, __ATOMIC_RELAXED, __HIP_MEMORY_SCOPE_AGENT); }
__device__ __forceinline__ unsigned xb_add(unsigned* p, unsigned v) { return __hip_atomic_fetch_add(p, v, __ATOMIC_RELAXED, __HIP_MEMORY_SCOPE_AGENT); }
__device__ __forceinline__ unsigned xb_xcc_id() { return (unsigned)__builtin_amdgcn_s_getreg((3 << 11) | 20) & 0xFu; }
#define XB_SPIN(cond, bar) do { unsigned _sp = 0; while (cond) { __builtin_amdgcn_s_sleep(1); \
    if ((++_sp & 255u) == 0u) { if (xb_ld(&(bar)[XB_TMO])) break; if (_sp > XB_SPIN_CAP) { atomicAdd(&(bar)[XB_TMO], 1u); break; } } } } while (0)

struct XcdBarrier {
    unsigned* bar; unsigned x; int wid;
    volatile LAS unsigned* st;
};

__device__ __forceinline__ bool xb_leader(int wid) { int l; asm volatile("v_mbcnt_lo_u32_b32 %0, -1, 0\n\tv_mbcnt_hi_u32_b32 %0, -1, %0" : "=v"(l)); return wid == 0 && l == 0; }
__device__ __forceinline__ XcdBarrier xcd_barrier_post(unsigned* bar, volatile LAS unsigned* st, int wid) {
    XcdBarrier b; b.bar = bar; b.x = xb_xcc_id(); b.st = st; b.wid = wid;
    if (xb_leader(wid)) (void)xb_add(&bar[XB_XCNT(b.x)], 1u);
    return b;
}
__device__ __forceinline__ void xcd_barrier_complete(unsigned* bar, unsigned x, unsigned& nloc, unsigned& nx) {
    const unsigned G = gridDim.x * gridDim.y * gridDim.z;
    unsigned sum, cnt, mine, sp = 0u;
    for (;;) {
        sum = 0u; cnt = 0u; mine = 0u;
#pragma unroll
        for (unsigned j = 0; j < 16; ++j) { const unsigned c = xb_ld(&bar[XB_XCNT(j)]); sum += c; cnt += (c > 0u) ? 1u : 0u; mine = (j == x) ? c : mine; }
        if (sum == G) break;
        __builtin_amdgcn_s_sleep(1);
        if ((++sp & 255u) == 0u) { if (xb_ld(&bar[XB_TMO])) break; if (sp > XB_SPIN_CAP) { atomicAdd(&bar[XB_TMO], 1u); break; } }
    }
    nloc = mine > 0u ? mine : 1u; nx = cnt > 0u ? cnt : 1u;
}

__device__ __forceinline__ void xcd_barrier(const XcdBarrier& b) {
    asm volatile("s_waitcnt vmcnt(0)" ::: "memory");
    __syncthreads();
    if (xb_leader(b.wid)) {
        unsigned* bar = b.bar; asm volatile("" : "+s"(bar));
        __builtin_amdgcn_s_waitcnt(0);
        unsigned nloc = b.st[0], nx = b.st[1];
        if (nloc == 0u) { xcd_barrier_complete(bar, b.x, nloc, nx); b.st[0] = nloc; b.st[1] = nx; }
        const unsigned old = xb_add(&bar[XB_XSUB(b.x)], 1u);
        const unsigned gen = old / nloc;
        if (old + 1u == (gen + 1u) * nloc) {
            __builtin_amdgcn_fence(__ATOMIC_RELEASE, "agent");
            asm volatile("s_waitcnt vmcnt(0)" ::: "memory");
            const unsigned og = xb_add(&bar[XB_TOP], 1u);
            const unsigned tg = og / nx;
            if (og + 1u == (tg + 1u) * nx) xb_add(&bar[XB_TOPGEN], 1u);
            else XB_SPIN(xb_ld(&bar[XB_TOPGEN]) == tg, bar);
            __builtin_amdgcn_fence(__ATOMIC_ACQUIRE, "agent");
            xb_add(&bar[XB_XGEN(b.x)], 1u);
            asm volatile("s_waitcnt vmcnt(0)" ::: "memory");
        } else {
            XB_SPIN(xb_ld(&bar[XB_XGEN(b.x)]) == gen, bar);
            __builtin_amdgcn_fence(__ATOMIC_ACQUIRE, "agent");
            asm volatile("s_waitcnt vmcnt(0)" ::: "memory");
        }
    }
    __syncthreads();
}

constexpr int NB = 4, SEQ = 8192, DM = 1024, NTOK = NB * SEQ, DEPTH = 2;
constexpr int W_IN_COLS = 7076;
constexpr int C_QA = 0, C_KA = 256, C_VA = 512, C_IQ = 768, C_IK = 896, C_IW = 928, C_UB = 932, C_VB = 1188, C_QC = 1444, C_KC = 1700, C_VC = 1956,
              C_BD = 2212, C_CD = 2468, C_XD = 2724, C_GATE = 2980;
constexpr int NEXP = 32, DEXP = 256, TOPK_SEL = 256;
constexpr float EPS = 1e-6f;
constexpr int NWAVES = 8, NTHR = 512;

constexpr size_t MiB = 1u << 20;
constexpr size_t WS_CTL = 0, CTL_ZERO_BYTES = 1 * MiB;
constexpr size_t WS_WP = 1 * MiB;
constexpr size_t WS_WV = 6 * MiB;
constexpr size_t WS_WG = 7 * MiB;
constexpr size_t WS_WB = 15 * MiB;
constexpr size_t WS_WO = 17 * MiB;
constexpr size_t WS_WGU = 19 * MiB;
constexpr size_t WS_WD = 51 * MiB;
constexpr size_t WS_WS = 67 * MiB;
constexpr size_t WS_ROPE = 68 * MiB;
constexpr size_t WS_MISC = 80 * MiB;
constexpr size_t WS_H = 84 * MiB;
constexpr size_t WS_Y = 148 * MiB;
constexpr size_t WS_BIG = 212 * MiB;
constexpr size_t WS_END = 468 * MiB;
constexpr size_t PO_QA = WS_BIG + 0 * MiB, PO_KA = WS_BIG + 16 * MiB, PO_UB = WS_BIG + 32 * MiB, PO_VB = WS_BIG + 48 * MiB, PO_QC = WS_BIG + 64 * MiB, PO_KC = WS_BIG + 80 * MiB,
                 PO_BD = WS_BIG + 96 * MiB, PO_CD = WS_BIG + 112 * MiB, PO_XD = WS_BIG + 128 * MiB,
                 PO_VT = WS_BIG + 144 * MiB,
                 PO_IQ = WS_BIG + 176 * MiB,
                 PO_IK = WS_BIG + 184 * MiB,
                 PO_SELM = WS_BIG + 192 * MiB;
constexpr int MOE_MAXROWS = 65536 + 32 * 256;
constexpr size_t MO_H2 = WS_BIG;
constexpr size_t WS_DELTA = WS_BIG + 192 * MiB;
constexpr size_t MO_HH = WS_BIG + 144 * MiB;
constexpr size_t MI_THR = WS_MISC;
constexpr size_t MI_IW = WS_MISC + 256 * 1024;
constexpr size_t MI_RSTD = WS_MISC + 768 * 1024;
constexpr size_t MI_EID = WS_MISC + 896 * 1024;
constexpr size_t MI_EW = WS_MISC + 1152 * 1024;
constexpr size_t MI_CNT = WS_MISC + 1408 * 1024;
constexpr size_t MI_RTOK = WS_MISC + 1536 * 1024;
constexpr size_t MI_RW = WS_MISC + 1536 * 1024 + 512 * 1024;
static_assert(MI_RW + MOE_MAXROWS * 4 <= WS_H, "misc region");
constexpr int CW_BAR = 4096;
constexpr int CW_TMO = 12288;
constexpr int CW_TCNT = 16384;
constexpr int TCNT_LAYER = 288 * 64;
static_assert((CW_TCNT + DEPTH * TCNT_LAYER) * 4 <= (int)CTL_ZERO_BYTES, "tile counters inside the zeroed control region");

constexpr int RING_BYTES = 131072;
constexpr int LDS_BYTES = 163840;
constexpr int MISC_OFF = LDS_BYTES - 256;
constexpr int TAB_OFF = RING_BYTES;

typedef unsigned short bf16;
typedef unsigned v4u __attribute__((ext_vector_type(4)));
typedef unsigned v2u __attribute__((ext_vector_type(2)));
typedef float f32x4 __attribute__((ext_vector_type(4)));
typedef float f32x2 __attribute__((ext_vector_type(2)));
typedef short bf16x8 __attribute__((ext_vector_type(8)));
#define LDS_WAIT() asm volatile("s_waitcnt lgkmcnt(0)" ::: "memory")
#define VM_WAIT() asm volatile("s_waitcnt vmcnt(0)" ::: "memory")
__device__ __forceinline__ unsigned pk2(float lo, float hi) { return pg8::cvt_pk_bf16(lo, hi); }
__device__ __forceinline__ float bf_lo(unsigned u) { return __builtin_bit_cast(float, u << 16); }
__device__ __forceinline__ float bf_hi(unsigned u) { return __builtin_bit_cast(float, u & 0xffff0000u); }
__device__ __forceinline__ float bf1(bf16 u) { return __builtin_bit_cast(float, (unsigned)u << 16); }
__device__ __forceinline__ float fexp2(float x) { return __builtin_amdgcn_exp2f(x); }
__device__ __forceinline__ float flog2(float x) { return __builtin_amdgcn_logf(x); }
__device__ __forceinline__ float frcp(float x) { return __builtin_amdgcn_rcpf(x); }
__device__ __forceinline__ int lane_id_opaque() { int l; asm volatile("v_mbcnt_lo_u32_b32 %0, -1, 0\n\tv_mbcnt_hi_u32_b32 %0, -1, %0" : "=v"(l)); return l; }
__device__ __forceinline__ float shx(float v, int mask, int lane) { return __builtin_bit_cast(float, __builtin_amdgcn_ds_bpermute((lane ^ mask) << 2, __builtin_bit_cast(int, v))); }
__device__ __forceinline__ float shdown(float v, int d, int lane) { return __builtin_bit_cast(float, __builtin_amdgcn_ds_bpermute(((lane + d) & 63) << 2, __builtin_bit_cast(int, v))); }
__device__ __forceinline__ unsigned shdown_u(unsigned v, int d, int lane) { return (unsigned)__builtin_amdgcn_ds_bpermute(((lane + d) & 63) << 2, (int)v); }
__device__ __forceinline__ unsigned shup_u(unsigned v, int d, int lane) { return (unsigned)__builtin_amdgcn_ds_bpermute(((lane - d) & 63) << 2, (int)v); }
__device__ __forceinline__ unsigned wave_prefix_incl_u(unsigned v) {
    v += (unsigned)__builtin_amdgcn_update_dpp(0, (int)v, 0x111, 0xf, 0xf, false);
    v += (unsigned)__builtin_amdgcn_update_dpp(0, (int)v, 0x112, 0xf, 0xf, false);
    v += (unsigned)__builtin_amdgcn_update_dpp(0, (int)v, 0x114, 0xf, 0xf, false);
    v += (unsigned)__builtin_amdgcn_update_dpp(0, (int)v, 0x118, 0xf, 0xf, false);
    v += (unsigned)__builtin_amdgcn_update_dpp(0, (int)v, 0x142, 0xa, 0xf, false);
    v += (unsigned)__builtin_amdgcn_update_dpp(0, (int)v, 0x143, 0xc, 0xf, false);
    return v;
}
__device__ __forceinline__ float wave_sum(float v, int lane) {
    (void)lane;
    v += __builtin_bit_cast(float, __builtin_amdgcn_update_dpp(0, __builtin_bit_cast(int, v), 0x111, 0xf, 0xf, false));
    v += __builtin_bit_cast(float, __builtin_amdgcn_update_dpp(0, __builtin_bit_cast(int, v), 0x112, 0xf, 0xf, false));
    v += __builtin_bit_cast(float, __builtin_amdgcn_update_dpp(0, __builtin_bit_cast(int, v), 0x114, 0xf, 0xf, false));
    v += __builtin_bit_cast(float, __builtin_amdgcn_update_dpp(0, __builtin_bit_cast(int, v), 0x118, 0xf, 0xf, false));
    v += __builtin_bit_cast(float, __builtin_amdgcn_update_dpp(0, __builtin_bit_cast(int, v), 0x142, 0xa, 0xf, false));
    v += __builtin_bit_cast(float, __builtin_amdgcn_update_dpp(0, __builtin_bit_cast(int, v), 0x143, 0xc, 0xf, false));
    return __builtin_bit_cast(float, __builtin_amdgcn_readlane(__builtin_bit_cast(int, v), 63));
}

__device__ __forceinline__ f32x4 idx_score(const bf16x8 A, const bf16x8 (&Bq)[4], const float (&clo)[4], const float (&chi)[4]) {
    const f32x4 z = {0.f, 0.f, 0.f, 0.f};
    const f32x4 d0 = __builtin_amdgcn_mfma_f32_16x16x32_bf16(A, Bq[0], z, 0, 0, 0), d1 = __builtin_amdgcn_mfma_f32_16x16x32_bf16(A, Bq[1], z, 0, 0, 0),
                d2 = __builtin_amdgcn_mfma_f32_16x16x32_bf16(A, Bq[2], z, 0, 0, 0), d3 = __builtin_amdgcn_mfma_f32_16x16x32_bf16(A, Bq[3], z, 0, 0, 0);
    f32x4 m0, m1, m2, m3;
#pragma unroll
    for (int r = 0; r < 4; ++r) { m0[r] = __builtin_amdgcn_fmed3f(d0[r], clo[0], chi[0]); m1[r] = __builtin_amdgcn_fmed3f(d1[r], clo[1], chi[1]); m2[r] = __builtin_amdgcn_fmed3f(d2[r], clo[2], chi[2]); m3[r] = __builtin_amdgcn_fmed3f(d3[r], clo[3], chi[3]); }
    return (((z + m0) + m1) + m2) + m3;
}
constexpr float IDX_SCALE = 8.0f;

#define CAS4 __attribute__((address_space(4)))
typedef const void* inptr_t;
struct Frame {
    LAS unsigned char* lds;
    volatile LAS unsigned* MISC;
    int tid, lane, wave, G, bid;
    unsigned char* ws;
    float* out;
    const CAS4 inptr_t* kin;
    __device__ __forceinline__ const float* x_in() const { return (const float*)kin[0]; }
    __device__ __forceinline__ const int* positions() const { return (const int*)kin[1]; }
    __device__ __forceinline__ const float* norm1_g() const { return (const float*)kin[2]; }
    __device__ __forceinline__ const float* w_in() const { return (const float*)kin[3]; }
    __device__ __forceinline__ const float* sgu_ln_g() const { return (const float*)kin[4]; }
    __device__ __forceinline__ const float* sgu_ln_b() const { return (const float*)kin[5]; }
    __device__ __forceinline__ const float* w_spatial() const { return (const float*)kin[6]; }
    __device__ __forceinline__ const float* b_spatial() const { return (const float*)kin[7]; }
    __device__ __forceinline__ const float* conv_w() const { return (const float*)kin[8]; }
    __device__ __forceinline__ const float* w_branch() const { return (const float*)kin[9]; }
    __device__ __forceinline__ const float* w_out() const { return (const float*)kin[10]; }
    __device__ __forceinline__ const float* norm2_g() const { return (const float*)kin[11]; }
    __device__ __forceinline__ const float* w_rg() const { return (const float*)kin[12]; }
    __device__ __forceinline__ const float* b_rg() const { return (const float*)kin[13]; }
    __device__ __forceinline__ const float* w_re() const { return (const float*)kin[14]; }
    __device__ __forceinline__ const float* b_re() const { return (const float*)kin[15]; }
    __device__ __forceinline__ const float* w_eg() const { return (const float*)kin[16]; }
    __device__ __forceinline__ const float* w_eu() const { return (const float*)kin[17]; }
    __device__ __forceinline__ const float* w_ed() const { return (const float*)kin[18]; }
    __device__ __forceinline__ const float* norm_f_g() const { return (const float*)kin[19]; }
};
template <class T> __device__ __forceinline__ T* wsp(const Frame& F, size_t off) { return (T*)(F.ws + off); }
template <class T> __device__ __forceinline__ T* launder_s(T* p) { asm volatile("" : "+s"(p)); return p; }
__device__ __forceinline__ Frame phase_frame(const Frame& F0) { Frame F = F0; int l = lane_id_opaque(); int w = F0.wave; asm volatile("" : "+s"(w));
    F.lane = l; F.wave = w; F.tid = w * 64 + l; F.ws = launder_s(F0.ws); F.kin = launder_s(F0.kin); return F; }

__device__ __forceinline__ int proj_col(int nr) {
    const int t = nr >> 8, c = nr & 255;
    if (t <= 1) { const int hh = c >> 6, w = c & 63, g = w >> 3, n = (w >> 2) & 1, e = w & 3; return (t == 0 ? C_QA : C_KA) + hh * 64 + n * 32 + 4 * g + e; }
    if (t == 2) {
        if (c < 160) { const int w = c & 31, fq = w >> 3, n = (w >> 2) & 1, e = w & 3, o = n * 16 + 4 * fq + e; return c < 128 ? C_IQ + (c >> 5) * 32 + o : C_IK + o; }
        if (c < 164) return C_IW + (c - 160);
        return -1;
    }
    switch (t) { case 3: return C_UB + c; case 4: return C_VB + c; case 5: return C_QC + c; case 6: return C_KC + c; case 7: return C_BD + c; case 8: return C_CD + c; default: return C_XD + c; }
}
__device__ __forceinline__ int gate_col(int nr) {
    const int pn = nr >> 8, c = nr & 255, bj = c >> 7, wc = (c >> 5) & 3, n = (c >> 4) & 1, fq = (c >> 2) & 3, e = c & 3;
    return C_GATE + (2 * bj + n) * 1024 + 64 * pn + 16 * wc + 4 * fq + e;
}
struct TrItem { const float* p4; int ld; bf16* dst; int K, n0, k0; float scale; };
constexpr int IT_WP = 16 * 80, IT_WV = 16 * 16, IT_WG = 16 * 128, IT_WB = 4 * 128, IT_WO = 16 * 32, IT_WGU = 16 * 512, IT_WD = 4 * 1024;
constexpr int IT_TOTAL = IT_WP + IT_WV + IT_WG + IT_WB + IT_WO + IT_WGU + IT_WD;
__device__ __forceinline__ TrItem tr_decode(const Frame& F, int layer, int it, int lane) {
    TrItem t; int r = it; const int c4 = (lane & 7) * 4; t.scale = 1.0f;
    const float* w_in = F.w_in() + (size_t)layer * DM * W_IN_COLS;
    if (r < IT_WP) { const int nb = r % 80, kb = r / 80, c = proj_col(nb * 32 + c4); t.p4 = c < 0 ? nullptr : w_in + c; t.ld = W_IN_COLS; t.dst = wsp<bf16>(F, WS_WP); t.K = 1024; t.n0 = nb * 32; t.k0 = kb * 64; }
    else if ((r -= IT_WP) < IT_WV) { const int nb = r % 16, kb = r / 16, nr = nb * 32 + c4; t.p4 = w_in + (nr < 256 ? C_VA + nr : C_VC + nr - 256); t.ld = W_IN_COLS; t.dst = wsp<bf16>(F, WS_WV); t.K = 1024; t.n0 = nb * 32; t.k0 = kb * 64; }
    else if ((r -= IT_WV) < IT_WG) { const int nb = r % 128, kb = r / 128; t.p4 = w_in + gate_col(nb * 32 + c4); t.ld = W_IN_COLS; t.dst = wsp<bf16>(F, WS_WG); t.K = 1024; t.n0 = nb * 32; t.k0 = kb * 64; }
    else if ((r -= IT_WG) < IT_WB) { const int nb = r % 128, kb = r / 128, nr = nb * 32 + c4; t.p4 = F.w_branch() + (size_t)layer * 4 * 256 * 1024 + (size_t)(nr >> 10) * 256 * 1024 + (nr & 1023); t.ld = 1024; t.scale = 8.0f; t.dst = wsp<bf16>(F, WS_WB); t.K = 256; t.n0 = nb * 32; t.k0 = kb * 64; }
    else if ((r -= IT_WB) < IT_WO) { const int nb = r % 32, kb = r / 32; t.p4 = F.w_out() + (size_t)layer * 1024 * 1024 + nb * 32 + c4; t.ld = 1024; t.scale = 0.125f; t.dst = wsp<bf16>(F, WS_WO); t.K = 1024; t.n0 = nb * 32; t.k0 = kb * 64; }
    else if ((r -= IT_WO) < IT_WGU) { const int nb = r % 512, kb = r / 512, nr = nb * 32 + c4, e = nr >> 9, rr = nr & 511, jj = rr >> 8, bj = (rr >> 7) & 1, f = 128 * jj + (rr & 127);
        t.p4 = (bj ? F.w_eu() : F.w_eg()) + (size_t)layer * NEXP * 1024 * 256 + (size_t)e * 1024 * 256 + f; t.ld = 256; t.dst = wsp<bf16>(F, WS_WGU); t.K = 1024; t.n0 = nb * 32; t.k0 = kb * 64; }
    else { r -= IT_WGU; const int nb = r % 1024, kb = r / 1024, nr = nb * 32 + c4; t.p4 = F.w_ed() + (size_t)layer * NEXP * 256 * 1024 + (size_t)(nr >> 10) * 256 * 1024 + (nr & 1023); t.ld = 1024; t.dst = wsp<bf16>(F, WS_WD); t.K = 256; t.n0 = nb * 32; t.k0 = kb * 64; }
    return t;
}
__device__ __forceinline__ void tr_load(const TrItem& t, int lane, f32x4 (&tv)[8]) {
#pragma unroll
    for (int i = 0; i < 8; ++i) { const int kk = 8 * i + (lane >> 3); tv[i] = t.p4 ? *(const f32x4*)(t.p4 + (size_t)(t.k0 + kk) * t.ld) : (f32x4){0.f, 0.f, 0.f, 0.f}; }
}
__device__ __forceinline__ void tr_store(const TrItem& t, int lane, const f32x4 (&tv)[8], LAS float* scr) {
#pragma unroll
    for (int i = 0; i < 8; ++i) { const int kk = 8 * i + (lane >> 3); *(LAS f32x4*)(scr + kk * 36 + (lane & 7) * 4) = tv[i]; }
    LDS_WAIT(); asm volatile("" ::: "memory");
    const int c = lane & 7;
#pragma unroll
    for (int j = 0; j < 4; ++j) { const int n = (lane >> 3) + 8 * j; const LAS float* s = scr + (8 * c) * 36 + n;
        const float sc = t.scale; v4u o; o.x = pk2(s[0 * 36] * sc, s[1 * 36] * sc); o.y = pk2(s[2 * 36] * sc, s[3 * 36] * sc); o.z = pk2(s[4 * 36] * sc, s[5 * 36] * sc); o.w = pk2(s[6 * 36] * sc, s[7 * 36] * sc);
        *(GAS v4u*)(t.dst + (size_t)(t.n0 + n) * t.K + t.k0 + 8 * c) = o; }
    LDS_WAIT(); asm volatile("" ::: "memory");
}
__device__ __forceinline__ void l0_weights(const Frame& F0, int layer) {
    const Frame F = phase_frame(F0);
    LAS float* scr = (LAS float*)(F.lds + F.wave * 16384);
    const int gw = F.bid * NWAVES + F.wave, NGW = F.G * NWAVES, lane = F.lane;
    if (gw < IT_TOTAL) {
        TrItem cur = tr_decode(F, layer, gw, lane); f32x4 tv[8]; tr_load(cur, lane, tv);
        for (int it = gw; it < IT_TOTAL; it += NGW) {
            const int itn = it + NGW; const bool more = itn < IT_TOTAL;
            TrItem nxt = cur; f32x4 tn[8];
            if (more) { nxt = tr_decode(F, layer, itn, lane); tr_load(nxt, lane, tn); }
            tr_store(cur, lane, tv, scr);
            if (more) { cur = nxt;
#pragma unroll
                for (int i = 0; i < 8; ++i) tv[i] = tn[i]; }
        }
    }
    const float* wsrc = F.w_spatial() + (size_t)layer * 4 * 128 * 128; bf16* wdst = wsp<bf16>(F, WS_WS);
    for (int i = F.bid * NTHR + F.tid; i < 4 * 128 * 128; i += F.G * NTHR) { const int s = i & 127, t = (i >> 7) & 127; const float v = s <= t ? wsrc[i] : 0.f; wdst[i] = (bf16)(pk2(v, 0.f) & 0xffffu); }
}
__device__ __forceinline__ void l0_rope(const Frame& F0) {
    const Frame F = phase_frame(F0);
    float* cosA = wsp<float>(F, WS_ROPE); float* sinA = cosA + (size_t)NTOK * 32; float* cosI = sinA + (size_t)NTOK * 32; float* sinI = cosI + (size_t)NTOK * 16;
    for (int i = F.bid * NTHR + F.tid; i < NTOK * 48; i += F.G * NTHR) {
        const int tok = i / 48, j = i % 48; const bool isA = j < 32; const int fi = isA ? j : j - 32;
        const float ex = isA ? (float)fi * (1.0f / 32.0f) : (float)fi * (1.0f / 16.0f);
        const float inv = exp2f(-ex * 13.287712379549449f);
        const float ang = (float)F.positions()[tok] * inv;
        double t = (double)ang * 0.15915494309189535; t -= floor(t);
        const float rev = (float)t; const float sn = __builtin_amdgcn_sinf(rev), cs = __builtin_amdgcn_cosf(rev);
        if (isA) { cosA[(size_t)tok * 32 + fi] = cs; sinA[(size_t)tok * 32 + fi] = sn; } else { cosI[(size_t)tok * 16 + fi] = cs; sinI[(size_t)tok * 16 + fi] = sn; }
    }
}
__device__ __forceinline__ int rowcol(int lane, int jj) { return 8 * lane + 512 * (jj >> 1) + 4 * (jj & 1); }
__device__ __forceinline__ void add_bf16x8(f32x4& lo, f32x4& hi, const v4u a) {
    lo.x += bf_lo(a.x); lo.y += bf_hi(a.x); lo.z += bf_lo(a.y); lo.w += bf_hi(a.y); hi.x += bf_lo(a.z); hi.y += bf_hi(a.z); hi.z += bf_lo(a.w); hi.w += bf_hi(a.w); }
template <int MODE, bool FINAL> __device__ __forceinline__ void rms_rows(const Frame& F0, int layer) {
    const Frame F = phase_frame(F0);
    const int prev = FINAL ? DEPTH - 1 : layer - 1;
    const float* xin = (MODE == 0 || prev == 0) ? F.x_in() : F.out; float* xout = F.out; const bf16* dl = wsp<bf16>(F, WS_DELTA); const bf16* y0 = wsp<bf16>(F, WS_Y); const bf16* y1 = wsp<bf16>(F, WS_H); bf16* h = wsp<bf16>(F, WS_H);
    const float* g = FINAL ? F.norm_f_g() : F.norm1_g() + layer * DM;
    const int gw = F.bid * NWAVES + F.wave, NGW = F.G * NWAVES, lane = F.lane;
    f32x4 gv[4];
#pragma unroll
    for (int jj = 0; jj < 4; ++jj) gv[jj] = *(const f32x4*)(g + rowcol(lane, jj));
    constexpr int RB = MODE == 0 ? 4 : 2;
    for (int m0 = gw; m0 < NTOK; m0 += NGW * RB) {
        f32x4 v[RB][4]; v4u ya[RB][2], yb[RB][2], yd[RB][2]; float s[RB];
#pragma unroll
        for (int rb = 0; rb < RB; ++rb) { const size_t ro = (size_t)(m0 + rb * NGW) * DM;
#pragma unroll
            for (int jj = 0; jj < 4; ++jj) v[rb][jj] = *(const GAS f32x4*)(xin + ro + rowcol(lane, jj));
            if (MODE == 1) {
#pragma unroll
                for (int jp = 0; jp < 2; ++jp) { const size_t o = ro + 8 * lane + 512 * jp; ya[rb][jp] = *(const GAS v4u*)(y0 + o); yb[rb][jp] = *(const GAS v4u*)(y1 + o); yd[rb][jp] = *(const GAS v4u*)(dl + o); } } }
#pragma unroll
        for (int rb = 0; rb < RB; ++rb) { s[rb] = 0.f;
            if (MODE == 1) {
#pragma unroll
                for (int jp = 0; jp < 2; ++jp) { add_bf16x8(v[rb][2 * jp], v[rb][2 * jp + 1], yd[rb][jp]); f32x4 t0 = {0.f, 0.f, 0.f, 0.f}, t1 = {0.f, 0.f, 0.f, 0.f}; add_bf16x8(t0, t1, ya[rb][jp]); add_bf16x8(t0, t1, yb[rb][jp]);
                    v[rb][2 * jp] += t0; v[rb][2 * jp + 1] += t1; } }
#pragma unroll
            for (int jj = 0; jj < 4; ++jj) s[rb] += (v[rb][jj].x * v[rb][jj].x + v[rb][jj].y * v[rb][jj].y) + (v[rb][jj].z * v[rb][jj].z + v[rb][jj].w * v[rb][jj].w); }
#pragma unroll
        for (int rb = 0; rb < RB; ++rb) { const size_t ro = (size_t)(m0 + rb * NGW) * DM;
            const float rstd = 1.0f / sqrtf(wave_sum(s[rb], lane) * (1.0f / DM) + EPS);
            if (FINAL) {
#pragma unroll
                for (int jj = 0; jj < 4; ++jj) *(GAS f32x4*)(xout + ro + rowcol(lane, jj)) = v[rb][jj] * rstd * gv[jj];
            } else {
                if (MODE == 1) {
#pragma unroll
                    for (int jj = 0; jj < 4; ++jj) *(GAS f32x4*)(xout + ro + rowcol(lane, jj)) = v[rb][jj]; }
#pragma unroll
                for (int jp = 0; jp < 2; ++jp) { const f32x4 t0 = v[rb][2 * jp] * rstd * gv[2 * jp], t1 = v[rb][2 * jp + 1] * rstd * gv[2 * jp + 1];
                    v4u w; w.x = pk2(t0.x, t0.y); w.y = pk2(t0.z, t0.w); w.z = pk2(t1.x, t1.y); w.w = pk2(t1.z, t1.w); *(GAS v4u*)(h + ro + 8 * lane + 512 * jp) = w; }
            }
        }
    }
}

typedef pg8::Unit Unit;

constexpr float LOG2E = 1.4426950408889634f;
__device__ __forceinline__ float sigmoidf_(float g) { return frcp(1.0f + fexp2(-g * LOG2E)); }
__device__ __forceinline__ float gelu_tanh(float x) { const float e = fexp2(x * (-2.302208198f + -0.102943240f * x * x)); return x * frcp(1.0f + e); }
__device__ __forceinline__ v4u pack8(const f32x4& a, const f32x4& b) { v4u w; w.x = pk2(a.x, a.y); w.y = pk2(a.z, a.w); w.z = pk2(b.x, b.y); w.w = pk2(b.z, b.w); return w; }

struct EpiStoreBf16 {
    static constexpr bool PERM = true, AFTER_DRAIN = false;
    bf16* O; int ldc; int pn_mask;
    __device__ __forceinline__ void operator()(const f32x4 (&acc)[2][2][4][2], const Unit& u, int wr, int wc, int fr, int fq) const {
        bf16* const O = launder_s(this->O);
        const int row0 = u.pm * 256 + wr * 64 + fr, col0 = (u.pn & pn_mask) * 256 + wc * 32 + 8 * fq;
#pragma unroll
        for (int ai = 0; ai < 2; ++ai)
#pragma unroll
            for (int m = 0; m < 4; ++m) { bf16* rowp = O + (size_t)(row0 + ai * 128 + m * 16) * ldc + col0;
#pragma unroll
                for (int bj = 0; bj < 2; ++bj) *(v4u*)(rowp + bj * 128) = pack8(acc[ai][bj][m][0], acc[ai][bj][m][1]); }
    }
};
struct EpiProj {
    static constexpr bool PERM = true, AFTER_DRAIN = false;
    unsigned char* ws;
    __device__ __forceinline__ void operator()(const f32x4 (&acc)[2][2][4][2], const Unit& u, int wr, int wc, int fr, int fq) const {
        unsigned char* const ws = launder_s(this->ws);
        const int t = u.pn, row0 = u.pm * 256 + wr * 64 + fr, col0 = wc * 32 + 8 * fq;
        const float* cosA = (const float*)(ws + WS_ROPE); const float* sinA = cosA + (size_t)NTOK * 32; const float* cosI = sinA + (size_t)NTOK * 32; const float* sinI = cosI + (size_t)NTOK * 16;
        if (t <= 1) {
            bf16* O = (bf16*)(ws + (t == 0 ? PO_QA : PO_KA)); const float sc = t == 0 ? 0.125f * LOG2E : 1.0f; const int g4 = ((wc & 1) * 4 + fq) * 4;
#pragma unroll
            for (int ai = 0; ai < 2; ++ai) {
                f32x4 cc[4], ss[4];
#pragma unroll
                for (int m = 0; m < 4; ++m) { const int row = row0 + ai * 128 + m * 16; cc[m] = *(const f32x4*)(cosA + (size_t)row * 32 + g4); ss[m] = *(const f32x4*)(sinA + (size_t)row * 32 + g4); }
#pragma unroll
                for (int m = 0; m < 4; ++m) { const int row = row0 + ai * 128 + m * 16; const f32x4 c4 = cc[m] * sc, s4 = ss[m] * sc;
#pragma unroll
                    for (int bj = 0; bj < 2; ++bj) { const f32x4 x1 = acc[ai][bj][m][0], x2 = acc[ai][bj][m][1];
                        *(v4u*)(O + (size_t)row * 256 + bj * 128 + col0) = pack8(x1 * c4 - x2 * s4, x2 * c4 + x1 * s4); } } }
        } else if (t == 2) {
            bf16* IQ = (bf16*)(ws + PO_IQ); bf16* IK = (bf16*)(ws + PO_IK); float* IW = (float*)(ws + MI_IW);
#pragma unroll
            for (int ai = 0; ai < 2; ++ai)
#pragma unroll
                for (int m = 0; m < 4; ++m) { const int row = row0 + ai * 128 + m * 16;
                    const f32x4 c4 = *(const f32x4*)(cosI + (size_t)row * 16 + 4 * fq), s4 = *(const f32x4*)(sinI + (size_t)row * 16 + 4 * fq);
                    { const f32x4 x1 = acc[ai][0][m][0], x2 = acc[ai][0][m][1]; *(v4u*)(IQ + (size_t)row * 128 + col0) = pack8(x1 * c4 - x2 * s4, x2 * c4 + x1 * s4); }
                    if (wc == 0) { const f32x4 x1 = acc[ai][1][m][0], x2 = acc[ai][1][m][1]; *(v4u*)(IK + (size_t)row * 32 + 8 * fq) = pack8(x1 * c4 - x2 * s4, x2 * c4 + x1 * s4); }
                    if (wc == 1 && fq == 0) *(f32x4*)(IW + (size_t)row * 4) = acc[ai][1][m][0]; }
        } else {
            size_t off; switch (t) { case 3: off = PO_UB; break; case 4: off = PO_VB; break; case 5: off = PO_QC; break; case 6: off = PO_KC; break; case 7: off = PO_BD; break; case 8: off = PO_CD; break; default: off = PO_XD; break; }
            bf16* O = (bf16*)(ws + off); const bool act = (t == 3 || t == 4); const float sc = t == 5 ? 0.125f : 1.0f;
#pragma unroll
            for (int ai = 0; ai < 2; ++ai)
#pragma unroll
                for (int m = 0; m < 4; ++m) { bf16* rowp = O + (size_t)(row0 + ai * 128 + m * 16) * 256 + col0;
#pragma unroll
                    for (int bj = 0; bj < 2; ++bj) { f32x4 a = acc[ai][bj][m][0] * sc, b = acc[ai][bj][m][1] * sc;
                        if (act) {
#pragma unroll
                            for (int e = 0; e < 4; ++e) { a[e] = gelu_tanh(a[e]); b[e] = gelu_tanh(b[e]); } }
                        *(v4u*)(rowp + bj * 128) = pack8(a, b); } }
        }
    }
};
__device__ __forceinline__ size_t p_index(int br, int row, int c) { return ((size_t)(br * 64 + (c >> 4)) * NTOK + row) * 16 + (c & 15); }
__device__ __forceinline__ unsigned fp8x4(const f32x4& v) {
    const float a = __builtin_amdgcn_fmed3f(v.x, -448.0f, 448.0f), b = __builtin_amdgcn_fmed3f(v.y, -448.0f, 448.0f), c = __builtin_amdgcn_fmed3f(v.z, -448.0f, 448.0f), d = __builtin_amdgcn_fmed3f(v.w, -448.0f, 448.0f);
    int w = __builtin_amdgcn_cvt_pk_fp8_f32(a, b, 0, false); w = __builtin_amdgcn_cvt_pk_fp8_f32(c, d, w, true); return (unsigned)w; }
struct EpiP {
    static constexpr bool PERM = true, AFTER_DRAIN = false;
    unsigned char* P;
    __device__ __forceinline__ void operator()(const f32x4 (&acc)[2][2][4][2], const Unit& u, int wr, int wc, int fr, int fq) const {
        unsigned char* const P = launder_s(this->P);
        const int br = u.pn >> 2, row0 = (u.pm & 127) * 256 + wr * 64 + fr, col0 = (u.pn & 3) * 256 + wc * 32 + 8 * fq;
#pragma unroll
        for (int ai = 0; ai < 2; ++ai)
#pragma unroll
            for (int m = 0; m < 4; ++m)
#pragma unroll
                for (int bj = 0; bj < 2; ++bj) { v2u w; w.x = fp8x4(acc[ai][bj][m][0]); w.y = fp8x4(acc[ai][bj][m][1]); *(v2u*)(P + p_index(br, row0 + ai * 128 + m * 16, col0 + bj * 128)) = w; }
    }
};
struct EpiGate {
    static constexpr bool PERM = false, AFTER_DRAIN = false;
    const unsigned char* P; bf16* merged;
    __device__ __forceinline__ void operator()(const f32x4 (&acc)[2][2][4][2], const Unit& u, int wr, int wc, int fr, int fq) const {
        const unsigned char* const P = launder_s(this->P); bf16* const merged = launder_s(this->merged);
        const int row0 = u.pm * 256 + wr * 64 + fr, cq = 64 * u.pn + 16 * wc + 4 * fq;
        unsigned pv[2][4][4];
#pragma unroll
        for (int ai = 0; ai < 2; ++ai)
#pragma unroll
            for (int m = 0; m < 4; ++m)
#pragma unroll
                for (int br = 0; br < 4; ++br) pv[ai][m][br] = *(const GAS unsigned*)(P + p_index(br, row0 + ai * 128 + m * 16, cq));
#pragma unroll
        for (int ai = 0; ai < 2; ++ai)
#pragma unroll
            for (int m = 0; m < 4; ++m) { const int row = row0 + ai * 128 + m * 16; f32x4 s = {0.f, 0.f, 0.f, 0.f};
#pragma unroll
                for (int bj = 0; bj < 2; ++bj)
#pragma unroll
                    for (int n = 0; n < 2; ++n) { const int p = (int)pv[ai][m][2 * bj + n]; const f32x4 g = acc[ai][bj][m][n];
                        const f32x2 lo = __builtin_amdgcn_cvt_pk_f32_fp8(p, false), hi = __builtin_amdgcn_cvt_pk_f32_fp8(p, true);
                        s.x += sigmoidf_(g.x) * lo.x; s.y += sigmoidf_(g.y) * lo.y; s.z += sigmoidf_(g.z) * hi.x; s.w += sigmoidf_(g.w) * hi.y; }
                v2u w; w.x = pk2(s.x, s.y); w.y = pk2(s.z, s.w); *(GAS v2u*)(merged + (size_t)row * 1024 + cq) = w; }
    }
};
struct EpiOut {
    static constexpr bool PERM = false, AFTER_DRAIN = false;
    const float* xin; float* xout;
    __device__ __forceinline__ void operator()(const f32x4 (&acc)[2][2][4][2], const Unit& u, int wr, int wc, int fr, int fq) const {
        const float* const xin = launder_s(this->xin); float* const xout = launder_s(this->xout);
        const int row0 = u.pm * 256 + wr * 64 + fr, col0 = u.pn * 256 + wc * 32 + 4 * fq;
#pragma unroll
        for (int ai = 0; ai < 2; ++ai) {
            f32x4 xv[4][2][2];
#pragma unroll
            for (int m = 0; m < 4; ++m)
#pragma unroll
                for (int bj = 0; bj < 2; ++bj)
#pragma unroll
                    for (int n = 0; n < 2; ++n) xv[m][bj][n] = *(const f32x4*)(xin + (size_t)(row0 + ai * 128 + m * 16) * DM + col0 + bj * 128 + n * 16);
#pragma unroll
            for (int m = 0; m < 4; ++m)
#pragma unroll
                for (int bj = 0; bj < 2; ++bj)
#pragma unroll
                    for (int n = 0; n < 2; ++n) *(f32x4*)(xout + (size_t)(row0 + ai * 128 + m * 16) * DM + col0 + bj * 128 + n * 16) = xv[m][bj][n] + acc[ai][bj][m][n];
        }
    }
};
struct EpiGU {
    static constexpr bool PERM = true, AFTER_DRAIN = false;
    const float* rw; bf16* hh;
    __device__ __forceinline__ void operator()(const f32x4 (&acc)[2][2][4][2], const Unit& u, int wr, int wc, int fr, int fq) const {
        const float* const rw = launder_s(this->rw); bf16* const hh = launder_s(this->hh);
        const int row0 = u.pm * 256 + wr * 64 + fr, f0 = 128 * (u.pn & 1) + wc * 32 + 8 * fq;
        const __amdgpu_buffer_rsrc_t hrs = __builtin_amdgcn_make_buffer_rsrc((void*)hh, 0, MOE_MAXROWS * 256 * 2, 0x00020000);
        float rwv[2][4];
#pragma unroll
        for (int ai = 0; ai < 2; ++ai)
#pragma unroll
            for (int m = 0; m < 4; ++m) rwv[ai][m] = rw[row0 + ai * 128 + m * 16];
#pragma unroll
        for (int ai = 0; ai < 2; ++ai)
#pragma unroll
            for (int m = 0; m < 4; ++m) { const int row = row0 + ai * 128 + m * 16; const float w = rwv[ai][m]; f32x4 o[2];
#pragma unroll
                for (int n = 0; n < 2; ++n)
#pragma unroll
                    for (int e = 0; e < 4; ++e) { const float g = acc[ai][0][m][n][e]; o[n][e] = g * sigmoidf_(g) * acc[ai][1][m][n][e] * w; }
                __builtin_amdgcn_raw_buffer_store_b128(pack8(o[0], o[1]), hrs, row * 512 + f0 * 2, 0, 16); }
    }
};
struct EpiDown {
    static constexpr bool PERM = true, AFTER_DRAIN = false;
    const int* rtok; bf16* y0; bf16* y1;
    __device__ __forceinline__ void operator()(const f32x4 (&acc)[2][2][4][2], const Unit& u, int wr, int wc, int fr, int fq) const {
        const int* const rtok = launder_s(this->rtok); bf16* const y0 = launder_s(this->y0); bf16* const y1 = launder_s(this->y1);
        const int row0 = u.pm * 256 + wr * 64 + fr, col0 = (u.pn & 3) * 256 + wc * 32 + 8 * fq;
        int tsv[2][4];
#pragma unroll
        for (int ai = 0; ai < 2; ++ai)
#pragma unroll
            for (int m = 0; m < 4; ++m) tsv[ai][m] = rtok[row0 + ai * 128 + m * 16];
#pragma unroll
        for (int ai = 0; ai < 2; ++ai)
#pragma unroll
            for (int m = 0; m < 4; ++m) { const int ts = tsv[ai][m];
                if (ts >= 0) { bf16* rowp = ((ts & 1) ? y1 : y0) + (size_t)(ts >> 1) * DM + col0;
#pragma unroll
                    for (int bj = 0; bj < 2; ++bj) *(v4u*)(rowp + bj * 128) = pack8(acc[ai][bj][m][0], acc[ai][bj][m][1]); } }
    }
};
struct POrder {
    int G, c;
    __device__ bool next(int i, Unit& u) const { const int L = i * G + c; if (L >= 2048) return false; const int n = L >> 9, r = L & 511; u.pm = __builtin_amdgcn_readfirstlane(n * 128 + (r >> 2)); u.pn = __builtin_amdgcn_readfirstlane(n * 4 + (r & 3)); return true; }
    __device__ __forceinline__ void a_ready(const Unit&) const {}
    __device__ __forceinline__ void done(const Unit&) const {}
};
struct Moe9Order {
    int G, c, ntile; const LAS int* tile_e; unsigned* tcnt;
    __device__ bool next(int i, Unit& u) const { const int L = i * G + c; if (L >= ntile * 2) return false; const int pm = L >> 1, j = L & 1; u.pm = __builtin_amdgcn_readfirstlane(pm); u.pn = __builtin_amdgcn_readfirstlane(tile_e[pm] * 2 + j); return true; }
    __device__ __forceinline__ void a_ready(const Unit&) const {}
    __device__ __forceinline__ void done(const Unit& u) const {
        asm volatile("s_waitcnt vmcnt(0)" ::: "memory");
        if (lane_id_opaque() == 0) (void)__hip_atomic_fetch_add(tcnt + 64 * u.pm, 1u, __ATOMIC_RELAXED, __HIP_MEMORY_SCOPE_AGENT);
    }
};
struct Moe10Order {
    int G, cv, nl, ntile; const LAS int* tile_e; unsigned* tcnt; unsigned* tmo; int wave;
    __device__ bool next(int i, Unit& u) const { const int r = cv < nl ? i : i + 2; const int m = (r < 2 ? r * nl : 2 * nl + (r - 2) * G) + cv; if (m >= ntile * 4) return false;
        const int pm = m >> 2, j = m & 3; u.pm = __builtin_amdgcn_readfirstlane(pm); u.pn = __builtin_amdgcn_readfirstlane(tile_e[pm] * 4 + j); return true; }
    __device__ __forceinline__ void a_ready(const Unit& u) const {
        if (wave == 0) {
            unsigned sp = 0u;
            while ((unsigned)__builtin_amdgcn_readfirstlane((int)__hip_atomic_load(tcnt + 64 * u.pm, __ATOMIC_RELAXED, __HIP_MEMORY_SCOPE_AGENT)) < 16u) {
                __builtin_amdgcn_s_sleep(2);
                if ((++sp & 255u) == 0u) { if (__builtin_amdgcn_readfirstlane((int)__hip_atomic_load(tmo, __ATOMIC_RELAXED, __HIP_MEMORY_SCOPE_AGENT)) != 0) break;
                    if (sp > (1u << 18)) { if (lane_id_opaque() == 0) __hip_atomic_store(tmo, 1u, __ATOMIC_RELAXED, __HIP_MEMORY_SCOPE_AGENT); break; } } }
            __builtin_amdgcn_fence(__ATOMIC_ACQUIRE, "agent");
            asm volatile("s_waitcnt vmcnt(0)" ::: "memory");
        }
        asm volatile("" ::: "memory"); __builtin_amdgcn_s_barrier(); asm volatile("" ::: "memory");
    }
    __device__ __forceinline__ void done(const Unit&) const {}
};

constexpr int TK_ROW = 1025;
constexpr int TK_STATE = 32 * TK_ROW * 4 + 64;
__device__ __forceinline__ unsigned fkey(float s) { const unsigned b = __builtin_bit_cast(unsigned, s); return b ^ ((unsigned)((int)b >> 31) | 0x80000000u); }
__device__ __forceinline__ float unkeyf(unsigned k) {
    if (k <= 0x007FFFFFu) return -__builtin_inff(); if (k >= 0xFF800000u) return __builtin_inff();
    return __builtin_bit_cast(float, (k & 0x80000000u) ? (k ^ 0x80000000u) : ~k);
}
__device__ __forceinline__ void lin_bin_range(int b, unsigned& klo, unsigned& width) {
    unsigned lo, hi; bool hi_max = false;
    if (b == 0) { lo = 0u; hi = fkey(-511.0f); }
    else if (b <= 511) { lo = fkey((float)(b - 512)); hi = (b == 511) ? 0x80000000u : fkey((float)(b - 511)); }
    else if (b == 512) { lo = 0x80000000u; hi = 0x80000001u; }
    else if (b <= 1022) { lo = fkey((float)(b - 513)) + 1u; hi = fkey((float)(b - 512)) + 1u; }
    else { lo = fkey(510.0f) + 1u; hi = 0u; hi_max = true; }
    klo = lo; width = hi_max ? (0u - lo) : (hi - lo);
}
__device__ __forceinline__ int tk_bin(float s) {
    const float c = __builtin_amdgcn_fmed3f(s, -512.0f, 511.0f);
    return 512 + (int)__builtin_copysignf(__builtin_ceilf(__builtin_fabsf(c)), c);
}
struct TkState { unsigned klo[32], width[32], shift[32], mode[32], r[32], T[32], I[32], more; };

__device__ __forceinline__ void topk_subunit(const Frame& F0, int b, int qt) {
    const Frame F = phase_frame(F0);
    LAS unsigned* hist = (LAS unsigned*)F.lds;
    LAS TkState* st = (LAS TkState*)(F.lds + TK_STATE);
    const int lane = F.lane, wave = F.wave, q16 = lane & 15, g = lane >> 4;
    const int tok0 = b * SEQ + 32 * qt;
    const bf16* IQ = wsp<bf16>(F, PO_IQ); const bf16* IK = wsp<bf16>(F, PO_IK); const float* IW = wsp<float>(F, MI_IW);
    bf16x8 Bq[2][4]; float clo[2][4], chi[2][4];
#pragma unroll
    for (int hf = 0; hf < 2; ++hf) { const int tok = tok0 + 16 * hf + q16; const f32x4 iw = *(const GAS f32x4*)(IW + (size_t)tok * 4);
#pragma unroll
        for (int h = 0; h < 4; ++h) { const v4u raw = *(const GAS v4u*)(IQ + (size_t)tok * 128 + h * 32 + 8 * g); const float w = iw[h] * IDX_SCALE;
            v4u o; o.x = pk2(bf_lo(raw.x) * w, bf_hi(raw.x) * w); o.y = pk2(bf_lo(raw.y) * w, bf_hi(raw.y) * w); o.z = pk2(bf_lo(raw.z) * w, bf_hi(raw.z) * w); o.w = pk2(bf_lo(raw.w) * w, bf_hi(raw.w) * w);
            Bq[hf][h] = __builtin_bit_cast(bf16x8, o); clo[hf][h] = w > 0.f ? 0.f : -__builtin_inff(); chi[hf][h] = w > 0.f ? __builtin_inff() : 0.f; } }
    if (F.tid < 32) { const int tq = 32 * qt + F.tid; const bool all = (tq + 1 <= TOPK_SEL);
        st->mode[F.tid] = all ? 0u : 3u; st->r[F.tid] = TOPK_SEL; st->T[F.tid] = 0u; st->I[F.tid] = 0xFFFFFFFFu; st->klo[F.tid] = 0u; st->width[F.tid] = 1u; st->shift[F.tid] = 0u; }
    if (F.tid == 0) st->more = 0u;
    const int nkt = 2 * (qt + 1);
    const char* const ikB = (const char*)IK + (size_t)b * SEQ * 64; const unsigned offA = (unsigned)q16 * 64u + (unsigned)g * 16u;
    int lim[2];
#pragma unroll
    for (int hf = 0; hf < 2; ++hf) lim[hf] = 32 * qt + 16 * hf + q16 - 4 * g;
    LAS unsigned* const hrow0 = hist + q16 * TK_ROW; LAS unsigned* const hrow1 = hist + (16 + q16) * TK_ROW;
#define TK_SCORE(hf_) const f32x4 sc = idx_score(A, Bq[hf_], clo[hf_], chi[hf_]);
    for (int pass = 0; pass < 12; ++pass) {
        for (int i = F.tid; i < 32 * TK_ROW / 4; i += NTHR) ((LAS v4u*)hist)[i] = (v4u){0u, 0u, 0u, 0u};
        __syncthreads();
        v4u A0b = *(const GAS v4u*)(ikB + (size_t)wave * 1024 + offA), A1b = *(const GAS v4u*)(ikB + (size_t)(wave + NWAVES < nkt ? wave + NWAVES : wave) * 1024 + offA);
#define TK_TWO_TILES() \
                const int kt1 = kt + NWAVES; const bool has1 = kt1 < nkt; f32x4 sA[2], sB[2]; \
                { const bf16x8 A = __builtin_bit_cast(bf16x8, A0b); { TK_SCORE(0); sA[0] = sc; } { TK_SCORE(1); sA[1] = sc; } } \
                { const int kn = kt + 2 * NWAVES; A0b = *(const GAS v4u*)(ikB + (size_t)(kn < nkt ? kn : 0) * 1024 + offA); } \
                { const bf16x8 A = __builtin_bit_cast(bf16x8, A1b); { TK_SCORE(0); sB[0] = sc; } { TK_SCORE(1); sB[1] = sc; } } \
                { const int kn = kt + 3 * NWAVES; A1b = *(const GAS v4u*)(ikB + (size_t)(kn < nkt ? kn : 0) * 1024 + offA); }
        if (pass == 0) {
            const bool lin0 = st->mode[q16] == 3u, lin1 = st->mode[16 + q16] == 3u; const unsigned linv0 = lin0 ? 1u : 0u, linv1 = lin1 ? 1u : 0u;
            for (int kt = wave; kt < nkt; kt += 2 * NWAVES) {
                TK_TWO_TILES();
                if (kt1 < 2 * qt) {
#pragma unroll
                    for (int tt = 0; tt < 2; ++tt)
#pragma unroll
                        for (int hf = 0; hf < 2; ++hf) {
                            LAS unsigned* const hrow = hf ? hrow1 : hrow0; const unsigned val = hf ? linv1 : linv0;
#pragma unroll
                            for (int r = 0; r < 4; ++r) __hip_atomic_fetch_add(hrow + tk_bin(tt ? sB[hf][r] : sA[hf][r]), val, __ATOMIC_RELAXED, __HIP_MEMORY_SCOPE_WORKGROUP);
                        }
                } else {
#pragma unroll
                    for (int tt = 0; tt < 2; ++tt)
#pragma unroll
                        for (int hf = 0; hf < 2; ++hf) {
                            LAS unsigned* const hrow = hf ? hrow1 : hrow0; const bool lin = (hf ? lin1 : lin0) & (tt == 0 || has1); const int ktt = tt ? kt1 : kt;
#pragma unroll
                            for (int r = 0; r < 4; ++r) { const float s = tt ? sB[hf][r] : sA[hf][r];
                                const unsigned val = (lin & (16 * ktt <= lim[hf] - r)) ? 1u : 0u;
                                __hip_atomic_fetch_add(hrow + tk_bin(s), val, __ATOMIC_RELAXED, __HIP_MEMORY_SCOPE_WORKGROUP); }
                        }
                }
            }
        } else {
            unsigned qmode[2], qklo[2], qwidth[2], qshift[2]; float qlo[2], qhi[2];
#pragma unroll
            for (int hf = 0; hf < 2; ++hf) { const int q = 16 * hf + q16; qmode[hf] = st->mode[q]; qklo[hf] = st->klo[q]; qwidth[hf] = st->width[q]; qshift[hf] = st->shift[q];
                const bool act = (qmode[hf] == 1u || qmode[hf] == 2u);
                qlo[hf] = act ? unkeyf(qklo[hf]) : __builtin_inff(); qhi[hf] = act ? unkeyf(qklo[hf] + (qwidth[hf] - 1u)) : -__builtin_inff(); }
            LDS_WAIT();
            for (int kt = wave; kt < nkt; kt += 2 * NWAVES) {
                TK_TWO_TILES();
#pragma unroll
                for (int tt = 0; tt < 2; ++tt)
#pragma unroll
                    for (int hf = 0; hf < 2; ++hf) {
                        LAS unsigned* const hrow = hf ? hrow1 : hrow0; const int ktt = tt ? kt1 : kt; const bool ok = (tt == 0 || has1);
                        bool in[4], anyin = false;
#pragma unroll
                        for (int r = 0; r < 4; ++r) { const float s = tt ? sB[hf][r] : sA[hf][r]; in[r] = (s >= qlo[hf]) & (s <= qhi[hf]) & (16 * ktt <= lim[hf] - r) & ok; anyin |= in[r]; }
                        if (__builtin_expect(anyin, 0)) {
#pragma unroll
                            for (int r = 0; r < 4; ++r) if (in[r]) { const float s = tt ? sB[hf][r] : sA[hf][r]; const unsigned d = fkey(s) - qklo[hf]; const int idx = 16 * ktt + 4 * g + r;
                                if (d < qwidth[hf]) {
                                    if (qmode[hf] == 1u) __hip_atomic_fetch_add(hrow + (d >> qshift[hf]), 1u, __ATOMIC_RELAXED, __HIP_MEMORY_SCOPE_WORKGROUP);
                                    else __hip_atomic_fetch_add(hrow + (idx >> 5), 1u << (idx & 31), __ATOMIC_RELAXED, __HIP_MEMORY_SCOPE_WORKGROUP); } } }
                    }
            }
        }
        __syncthreads();
#pragma unroll 1
        for (int qi = 0; qi < 4; ++qi) {
            const int q = 4 * wave + qi; const unsigned mode = st->mode[q]; if (mode == 0u) continue;
            const LAS unsigned* hrow = hist + q * TK_ROW; const unsigned rr = st->r[q];
            if (mode != 2u) {
                unsigned wv[16]; unsigned c = 0;
#pragma unroll
                for (int i = 0; i < 4; ++i) { const v4u t = *(const LAS v4u*)(hrow + 16 * lane + 4 * i); wv[4 * i] = t.x; wv[4 * i + 1] = t.y; wv[4 * i + 2] = t.z; wv[4 * i + 3] = t.w; }
#pragma unroll
                for (int i = 0; i < 16; ++i) c += wv[i];
                const unsigned pin = wave_prefix_incl_u(c), tot = (unsigned)__builtin_amdgcn_readlane((int)pin, 63);
                const unsigned above = tot - pin, incl = above + c;
                if (above < rr && rr <= incl) {
                    unsigned cum = above; int bsel = -1; unsigned csel = 0, rsel = 0;
#pragma unroll
                    for (int i = 15; i >= 0; --i) { if (bsel < 0 && cum + wv[i] >= rr) { bsel = 16 * lane + i; csel = wv[i]; rsel = rr - cum; } cum += wv[i]; }
                    unsigned klo, width;
                    if (mode == 3u) lin_bin_range(bsel, klo, width);
                    else { const unsigned sh = st->shift[q], ok = st->klo[q], ow = st->width[q]; const unsigned off = (unsigned)bsel << sh; klo = ok + off; const unsigned rem = ow - off, cap = 1u << sh; width = rem < cap ? rem : cap; }
                    if (csel == rsel) { st->mode[q] = 0u;
                        if (klo == 0x80000000u) { st->T[q] = klo; st->I[q] = 8191u; }
                        else { st->T[q] = klo ? klo - 1u : 0u; st->I[q] = 0xFFFFFFFFu; } }
                    else { st->klo[q] = klo; st->width[q] = width; st->r[q] = rsel;
                        if (width == 1u) st->mode[q] = 2u; else { st->mode[q] = 1u; const int nb = 32 - __builtin_clz(width - 1u); st->shift[q] = nb > 10 ? (unsigned)(nb - 10) : 0u; }
                        st->more = 1u; }
                }
            } else {
                const v4u t = *(const LAS v4u*)(hrow + 4 * lane); const unsigned c = __builtin_popcount(t.x) + __builtin_popcount(t.y) + __builtin_popcount(t.z) + __builtin_popcount(t.w);
                const unsigned incl = wave_prefix_incl_u(c);
                const unsigned below = incl - c;
                if (below < rr && rr <= incl) {
                    unsigned need = rr - below; unsigned wsel = 0; int wi = 0; bool found = false;
                    const unsigned ws4[4] = {t.x, t.y, t.z, t.w};
#pragma unroll
                    for (int i = 0; i < 4; ++i) { const unsigned pc = __builtin_popcount(ws4[i]); if (!found) { if (need <= pc) { wsel = ws4[i]; wi = i; found = true; } else need -= pc; } }
                    unsigned m = wsel; for (unsigned k = 1; k < need; ++k) m &= m - 1u;
                    const int bit = __builtin_ctz(m);
                    st->mode[q] = 0u; st->T[q] = st->klo[q]; st->I[q] = (unsigned)((4 * lane + wi) * 32 + bit);
                }
            }
        }
        __syncthreads();
        const unsigned more = st->more;
        __syncthreads();
        if (F.tid == 0) st->more = 0u;
        if (!more) break;
    }
#undef TK_SCORE
#undef TK_TWO_TILES
    __syncthreads();
    if (F.tid < 32) { const unsigned T = st->T[F.tid]; float* thr = wsp<float>(F, MI_THR) + (size_t)(tok0 + F.tid) * 2;
        thr[0] = unkeyf(T); ((int*)thr)[1] = (int)st->I[F.tid]; }
    __syncthreads();
}


constexpr int DS_KA = 0, DS_VT = 34816, DS_STAGE = 34816 + 40960, DS_MASK = 2 * DS_STAGE, DS_END = DS_MASK + 8192;
constexpr float DS_MARGIN = 16.0f, DS_BIG = 32768.0f;
static_assert(DS_END <= MISC_OFF, "DSA LDS map");
__device__ __forceinline__ void dsa_subunit(const Frame& F0, int b, int qt) {
    const Frame F = phase_frame(F0);
    const int lane = F.lane, wave = F.wave, q16 = lane & 15, g = lane >> 4, qg = wave & 3, hp = wave >> 2;
    LAS unsigned char* L = F.lds;
    const bf16* QA = wsp<bf16>(F, PO_QA); const bf16* KA = wsp<bf16>(F, PO_KA); const bf16* VT = wsp<bf16>(F, PO_VT);
    const bf16* IQ = wsp<bf16>(F, PO_IQ); const bf16* IK = wsp<bf16>(F, PO_IK); const float* IW = wsp<float>(F, MI_IW); const float* THR = wsp<float>(F, MI_THR);
    bf16* YA = wsp<bf16>(F, WS_Y);
    const int tq = 64 * qt + 16 * qg + q16, tok = b * SEQ + tq;
    bf16x8 Bq[4], Q[2][2]; float clo[4], chi[4];
    { const f32x4 iw = *(const GAS f32x4*)(IW + (size_t)tok * 4);
#pragma unroll
      for (int h = 0; h < 4; ++h) { const v4u raw = *(const GAS v4u*)(IQ + (size_t)tok * 128 + h * 32 + 8 * g); const float w = iw[h] * IDX_SCALE;
          v4u o; o.x = pk2(bf_lo(raw.x) * w, bf_hi(raw.x) * w); o.y = pk2(bf_lo(raw.y) * w, bf_hi(raw.y) * w); o.z = pk2(bf_lo(raw.z) * w, bf_hi(raw.z) * w); o.w = pk2(bf_lo(raw.w) * w, bf_hi(raw.w) * w);
          Bq[h] = __builtin_bit_cast(bf16x8, o); clo[h] = w > 0.f ? 0.f : -__builtin_inff(); chi[h] = w > 0.f ? __builtin_inff() : 0.f; }
#pragma unroll
      for (int hh = 0; hh < 2; ++hh)
#pragma unroll
          for (int ks = 0; ks < 2; ++ks) Q[hh][ks] = __builtin_bit_cast(bf16x8, *(const GAS v4u*)(QA + (size_t)tok * 256 + (2 * hp + hh) * 64 + ks * 32 + 8 * g)); }
    const float Tf = THR[(size_t)tok * 2]; const int Iraw = ((const int*)THR)[(size_t)tok * 2 + 1]; const int limQ = tq - 8 * g, limI = Iraw - 8 * g;
    const bool anytie = __builtin_amdgcn_ballot_w64(Iraw >= 0) != 0ull;
    f32x4 O[2][4]; float mref[2], lrun[2]; bool seen[2];
#pragma unroll
    for (int hh = 0; hh < 2; ++hh) { mref[hh] = 0.f; lrun[hh] = 0.f; seen[hh] = false;
#pragma unroll
        for (int dt = 0; dt < 4; ++dt) O[hh][dt] = (f32x4){0.f, 0.f, 0.f, 0.f}; }
    unsigned goff[10];
#pragma unroll
    for (int i = 0; i < 10; ++i) { const int p = wave + 8 * i;
        if (p < 34) { const int c = 64 * p + lane, row = c / 34, part = c % 34, s = row >> 5, tau = (row >> 4) & 1, ii = row & 15, key = 32 * s + 8 * (ii >> 2) + 4 * tau + (ii & 3);
            goff[i] = (unsigned)key * 512u + (unsigned)(part < 32 ? part : 31) * 16u; }
        else { const int c = 64 * (p - 34) + lane, row = c / 10, w = c % 10, s = w / 5, part = w % 5;
            goff[i] = (unsigned)row * (unsigned)(NTOK * 2) + (unsigned)(32 * s + 8 * (part < 4 ? part : 3)) * 2u; } }
    const char* const kaB0 = (const char*)KA + (size_t)b * SEQ * 512; const char* const vtB0 = (const char*)VT + (size_t)b * SEQ * 2;
#define DSA_DMA(it_, buf_) do { const char* kaB = kaB0 + (size_t)(it_) * (64 * 512); const char* vtB = vtB0 + (size_t)(it_) * 128; LAS unsigned char* Ls = L + (buf_) * DS_STAGE; \
        _Pragma("unroll") for (int i = 0; i < 10; ++i) { const int p = wave + 8 * i; \
            if (p < 34) __builtin_amdgcn_global_load_lds((const unsigned*)(kaB + goff[i]), (LAS unsigned*)(Ls + DS_KA + p * 1024), 16, 0, 0); \
            else if (p < 74) __builtin_amdgcn_global_load_lds((const unsigned*)(vtB + goff[i]), (LAS unsigned*)(Ls + DS_VT + (p - 34) * 1024), 16, 0, 0); } } while (0)
    const char* const ikB0 = (const char*)IK + ((size_t)b * SEQ + 32 * hp + 8 * (q16 >> 2) + (q16 & 3)) * 64 + g * 16;
#define DSA_IKLD(it_, d0_, d1_) do { const char* p_ = ikB0 + (size_t)(it_) * (64 * 64); d0_ = *(const GAS v4u*)(p_); d1_ = *(const GAS v4u*)(p_ + 4 * 64); } while (0)
#define DSA_MASK(it_, buf_, I0_, I1_) do { unsigned mw0 = 0u, mw1 = 0u; const int kb_ = 64 * (it_) + 32 * hp; \
        const f32x4 sc0_ = idx_score(__builtin_bit_cast(bf16x8, I0_), Bq, clo, chi), sc1_ = idx_score(__builtin_bit_cast(bf16x8, I1_), Bq, clo, chi); \
        if ((it_) < qt && !anytie) { \
            _Pragma("unroll") for (int r = 0; r < 4; ++r) { mw0 |= (sc0_[r] > Tf) ? 0u : (0xffu << (8 * r)); mw1 |= (sc1_[r] > Tf) ? 0u : (0xffu << (8 * r)); } \
        } else { \
            _Pragma("unroll") for (int tau = 0; tau < 2; ++tau) _Pragma("unroll") for (int r = 0; r < 4; ++r) { const float s = tau ? sc1_[r] : sc0_[r]; \
                const int e = kb_ + 4 * tau + r; const bool sel = (e <= limQ) & ((s > Tf) | ((s == Tf) & (e <= limI))); \
                const unsigned nb = sel ? 0u : (0xffu << (8 * r)); if (tau) mw1 |= nb; else mw0 |= nb; } } \
        v2u mw_; mw_.x = mw0; mw_.y = mw1; *(LAS v2u*)(L + DS_MASK + (((buf_) * 4 + qg) * 2 + hp) * 512 + lane * 8) = mw_; } while (0)
#ifndef DSA_NO_SDWA
#define DSA_BIAS(B_, dst_, m_) asm("v_lshlrev_b32_sdwa %0, 23, sext(%1) dst_sel:DWORD dst_unused:UNUSED_PAD src0_sel:DWORD src1_sel:BYTE_" #B_ : "=v"(dst_) : "v"(m_))
#else
#define DSA_BIAS(B_, dst_, m_) dst_ = __builtin_bit_cast(float, (unsigned)(((int)((m_) << (24 - 8 * (B_))) >> 31)) & 0xff800000u)
#endif
    v4u nk0 = (v4u){0u, 0u, 0u, 0u}, nk1 = (v4u){0u, 0u, 0u, 0u};
    { v4u i0, i1; DSA_IKLD(0, i0, i1); DSA_DMA(0, 0); if (hp == 1) DSA_IKLD(qt > 0 ? 1 : 0, nk0, nk1); DSA_MASK(0, 0, i0, i1); }
    VM_WAIT();
    __syncthreads();
    const LAS unsigned char* const kRow = L + DS_KA + q16 * 544 + g * 16;
    const LAS unsigned char* const vRow = L + DS_VT + q16 * 160 + g * 16;
#define DSA_KLD(dst, c_) do { const int hh_ = (c_) & 1, s_ = (c_) >> 1; _Pragma("unroll") for (int tau = 0; tau < 2; ++tau) _Pragma("unroll") for (int ks = 0; ks < 2; ++ks) \
        dst[tau][ks] = *(const LAS bf16x8*)(kRow + cur * DS_STAGE + (32 * s_ + 16 * tau) * 544 + (2 * hp + hh_) * 128 + ks * 64); } while (0)
    for (int it = 0; it <= qt; ++it) {
        const int cur = it & 1;
        if (it < qt) {
            if (hp == 1) DSA_MASK(it + 1, cur ^ 1, nk0, nk1);
            DSA_DMA(it + 1, cur ^ 1);
            { const int itn = hp == 1 ? (it + 2 <= qt ? it + 2 : qt) : it + 1; DSA_IKLD(itn, nk0, nk1); }
        }
        f32x4 bias[2][2]; bool anysel[2];
#pragma unroll
        for (int s = 0; s < 2; ++s) { const v2u mw = *(const LAS v2u*)(L + DS_MASK + ((cur * 4 + qg) * 2 + s) * 512 + lane * 8); const unsigned m0 = mw.x, m1 = mw.y; float b0, b1, b2, b3; anysel[s] = (m0 & m1) != 0xffffffffu;
            DSA_BIAS(0, b0, m0); DSA_BIAS(1, b1, m0); DSA_BIAS(2, b2, m0); DSA_BIAS(3, b3, m0); bias[s][0] = (f32x4){b0, b1, b2, b3};
            DSA_BIAS(0, b0, m1); DSA_BIAS(1, b1, m1); DSA_BIAS(2, b2, m1); DSA_BIAS(3, b3, m1); bias[s][1] = (f32x4){b0, b1, b2, b3}; }
        bf16x8 Kf[2][2];
        DSA_KLD(Kf, 0);
        const bf16x8 ONES = __builtin_bit_cast(bf16x8, (v4u){0x3f803f80u, 0x3f803f80u, 0x3f803f80u, 0x3f803f80u});
#pragma unroll
        for (int c = 0; c < 4; ++c) {
            const int hh = c & 1, s = c >> 1, h = 2 * hp + hh;
            f32x4 S[2];
#pragma unroll
            for (int tau = 0; tau < 2; ++tau) { const f32x4 ci = bias[s][tau] - mref[hh];
                S[tau] = __builtin_amdgcn_mfma_f32_16x16x32_bf16(Kf[tau][0], Q[hh][0], ci, 0, 0, 0);
                S[tau] = __builtin_amdgcn_mfma_f32_16x16x32_bf16(Kf[tau][1], Q[hh][1], S[tau], 0, 0, 0); }
            bf16x8 Vf[4], Kn[2][2];
#pragma unroll
            for (int dt = 0; dt < 4; ++dt) Vf[dt] = *(const LAS bf16x8*)(vRow + cur * DS_STAGE + (h * 64 + 16 * dt) * 160 + s * 80);
            if (c < 3) DSA_KLD(Kn, c + 1);
            float a[8];
#pragma unroll
            for (int r = 0; r < 4; ++r) { a[r] = S[0][r]; a[4 + r] = S[1][r]; }
            float p[8];
#pragma unroll
            for (int j = 0; j < 8; ++j) p[j] = fexp2(a[j]);
            v4u pw; pw.x = pk2(p[0], p[1]); pw.y = pk2(p[2], p[3]); pw.z = pk2(p[4], p[5]); pw.w = pk2(p[6], p[7]);
            bf16x8 P = __builtin_bit_cast(bf16x8, pw);
            f32x4 lst = __builtin_amdgcn_mfma_f32_16x16x32_bf16(ONES, P, (f32x4){0.f, 0.f, 0.f, 0.f}, 0, 0, 0);
            const bool trig = !(lst[0] <= DS_BIG) | (!seen[hh] & anysel[s]);
            if (__builtin_amdgcn_ballot_w64(trig) != 0ull) {
#pragma unroll
                for (int tau = 0; tau < 2; ++tau) { const f32x4 ci = bias[s][tau] - mref[hh];
                    S[tau] = __builtin_amdgcn_mfma_f32_16x16x32_bf16(Kf[tau][0], Q[hh][0], ci, 0, 0, 0);
                    S[tau] = __builtin_amdgcn_mfma_f32_16x16x32_bf16(Kf[tau][1], Q[hh][1], S[tau], 0, 0, 0); }
#pragma unroll
                for (int r = 0; r < 4; ++r) { a[r] = S[0][r]; a[4 + r] = S[1][r]; }
                const float mx = fmaxf(fmaxf(fmaxf(a[0], a[1]), fmaxf(a[2], a[3])), fmaxf(fmaxf(a[4], a[5]), fmaxf(a[6], a[7])));
                float rmx = fmaxf(mx, shx(mx, 16, lane)); rmx = fmaxf(rmx, shx(rmx, 32, lane));
                const bool any = rmx > -__builtin_inff();
                const float delta = seen[hh] ? fmaxf(rmx, 0.f) : (any ? rmx : 0.f);
                seen[hh] = seen[hh] | any; mref[hh] += delta; const float alpha = fexp2(-delta); lrun[hh] *= alpha;
#pragma unroll
                for (int dt = 0; dt < 4; ++dt) O[hh][dt] = O[hh][dt] * alpha;
#pragma unroll
                for (int j = 0; j < 8; ++j) p[j] = fexp2(a[j] - delta);
                pw.x = pk2(p[0], p[1]); pw.y = pk2(p[2], p[3]); pw.z = pk2(p[4], p[5]); pw.w = pk2(p[6], p[7]);
                P = __builtin_bit_cast(bf16x8, pw);
                lst = __builtin_amdgcn_mfma_f32_16x16x32_bf16(ONES, P, (f32x4){0.f, 0.f, 0.f, 0.f}, 0, 0, 0);
            }
            lrun[hh] += lst[0];
#pragma unroll
            for (int dt = 0; dt < 4; ++dt) O[hh][dt] = __builtin_amdgcn_mfma_f32_16x16x32_bf16(Vf[dt], P, O[hh][dt], 0, 0, 0);
            if (c < 3) {
#pragma unroll
                for (int tau = 0; tau < 2; ++tau) { Kf[tau][0] = Kn[tau][0]; Kf[tau][1] = Kn[tau][1]; } }
        }
        if (hp == 0 && it < qt) DSA_MASK(it + 1, cur ^ 1, nk0, nk1);
        VM_WAIT();
        __syncthreads();
    }
#undef DSA_DMA
#undef DSA_IKLD
#undef DSA_MASK
#undef DSA_BIAS
#undef DSA_KLD
#pragma unroll
    for (int hh = 0; hh < 2; ++hh) {
        const float inv = 1.0f / lrun[hh];
#pragma unroll
        for (int dt = 0; dt < 4; ++dt) { const f32x4 o = O[hh][dt] * inv; v2u w; w.x = pk2(o.x, o.y); w.y = pk2(o.z, o.w);
            *(GAS v2u*)(YA + (size_t)tok * 256 + (2 * hp + hh) * 64 + 16 * dt + 4 * g) = w; }
    }
    __syncthreads();
}

constexpr int SB_KC = 0, SB_VT = 16896, SB_STAGE = 16896 + 20480, SB_FLAGS = 2 * SB_STAGE;
constexpr float SB_EXIT = -110.0f, LN2 = 0.6931471805599453f;
__device__ __forceinline__ void sb_subunit(const Frame& F0, int b, int qt) {
    const Frame F = phase_frame(F0);
    const int tid = F.tid, lane = F.lane, wave = F.wave, q16 = lane & 15, g = lane >> 4, qg = wave & 3, hp = wave >> 2;
    LAS unsigned char* L = F.lds;
    const bf16* QC = wsp<bf16>(F, PO_QC); const bf16* KC = wsp<bf16>(F, PO_KC); const bf16* VT = wsp<bf16>(F, PO_VT) + (size_t)256 * NTOK;
    bf16* YC = wsp<bf16>(F, WS_Y) + (size_t)2 * NTOK * 256;
    LAS unsigned* flags = (LAS unsigned*)(L + SB_FLAGS);
    const int tq = 64 * qt + 16 * qg + q16, tok = b * SEQ + tq, tq_max = 64 * qt + 16 * qg + 15;
    bf16x8 Q[2][2];
#pragma unroll
    for (int hh = 0; hh < 2; ++hh)
#pragma unroll
        for (int ks = 0; ks < 2; ++ks) Q[hh][ks] = __builtin_bit_cast(bf16x8, *(const GAS v4u*)(QC + (size_t)tok * 256 + (2 * hp + hh) * 64 + ks * 32 + 8 * g));
    f32x4 O[2][4]; float Lrun[2] = {0.f, 0.f};
#pragma unroll
    for (int hh = 0; hh < 2; ++hh)
#pragma unroll
        for (int dt = 0; dt < 4; ++dt) O[hh][dt] = (f32x4){0.f, 0.f, 0.f, 0.f};
    v4u sK[2], sV[2];
    const size_t kbase = (size_t)b * SEQ;
#define SB_LOAD(kt_) do { const size_t k0 = kbase + 32 * (size_t)(kt_); \
        _Pragma("unroll") for (int i = 0; i < 2; ++i) { const int c = tid + 512 * i; sK[i] = *(const GAS v4u*)(KC + k0 * 256 + (size_t)c * 8); \
            sV[i] = *(const GAS v4u*)(VT + (size_t)(c >> 2) * NTOK + k0 + (c & 3) * 8); } } while (0)
#define SB_STORE(buf_) do { LAS unsigned char* Lb = L + (buf_) * SB_STAGE; \
        _Pragma("unroll") for (int i = 0; i < 2; ++i) { const int c = tid + 512 * i; *(LAS v4u*)(Lb + SB_KC + (c >> 5) * 528 + (c & 31) * 16) = sK[i]; \
            *(LAS v4u*)(Lb + SB_VT + (c >> 2) * 80 + (c & 3) * 16) = sV[i]; } } while (0)
    const int kt_top = 2 * qt + 1;
    SB_LOAD(kt_top); SB_STORE(0);
    __syncthreads();
    const int krow0 = 8 * (q16 >> 2) + (q16 & 3);
    for (int i = 0; i <= kt_top; ++i) {
        const int kt = kt_top - i; const LAS unsigned char* Lb = L + (i & 1) * SB_STAGE;
        if (kt > 0) SB_LOAD(kt - 1);
        if (32 * kt < tq_max) {
            float lbv[2][8], sufv[2][8], runv[2];
            LAS float* const xg = (LAS float*)(L + SB_FLAGS + 64) + ((wave * 2) * 16 + q16) * 4;
#pragma unroll
            for (int hh = 0; hh < 2; ++hh) {
                const int h = 2 * hp + hh;
                f32x4 S[2];
#pragma unroll
                for (int tau = 0; tau < 2; ++tau) { const LAS unsigned char* kp = Lb + SB_KC + (krow0 + 4 * tau) * 528 + h * 128 + g * 16;
                    S[tau] = __builtin_amdgcn_mfma_f32_16x16x32_bf16(*(const LAS bf16x8*)(kp), Q[hh][0], (f32x4){0.f, 0.f, 0.f, 0.f}, 0, 0, 0);
                    S[tau] = __builtin_amdgcn_mfma_f32_16x16x32_bf16(*(const LAS bf16x8*)(kp + 64), Q[hh][1], S[tau], 0, 0, 0); }
                float lk[8];
#pragma unroll
                for (int j = 0; j < 8; ++j) { const float z = j < 4 ? S[0][j] : S[1][j - 4]; const int idx = 32 * kt + 8 * g + j; const bool valid = idx < tq;
                    const float az = fabsf(z), e = fexp2(-az * LOG2E), sp = flog2(1.0f + e) * LN2;
                    const float k_ = -(fmaxf(z, 0.f) + sp);
                    lk[j] = valid ? k_ : 0.f; lbv[hh][j] = valid ? (k_ + z) : -__builtin_inff(); }
                float run = 0.f;
#pragma unroll
                for (int j = 7; j >= 0; --j) { sufv[hh][j] = run; run += lk[j]; }
                runv[hh] = run; xg[hh * 64 + g] = run;
            }
#pragma unroll
            for (int hh = 0; hh < 2; ++hh) {
                const int h = 2 * hp + hh;
                const f32x4 r4 = *(const LAS f32x4*)(xg + hh * 64);
                const float hi = (g < 1 ? r4.y : 0.f) + (g < 2 ? r4.z : 0.f) + (g < 3 ? r4.w : 0.f), tt = (r4.x + r4.y) + (r4.z + r4.w);
                const float base = Lrun[hh] + hi;
                float a[8];
#pragma unroll
                for (int j = 0; j < 8; ++j) a[j] = fexp2((lbv[hh][j] + base + sufv[hh][j]) * LOG2E);
                Lrun[hh] += tt;
                v4u pw; pw.x = pk2(a[0], a[1]); pw.y = pk2(a[2], a[3]); pw.z = pk2(a[4], a[5]); pw.w = pk2(a[6], a[7]);
                const bf16x8 P = __builtin_bit_cast(bf16x8, pw);
#pragma unroll
                for (int dt = 0; dt < 4; ++dt) { const bf16x8 V = *(const LAS bf16x8*)(Lb + SB_VT + (h * 64 + 16 * dt + q16) * 80 + g * 16);
                    O[hh][dt] = __builtin_amdgcn_mfma_f32_16x16x32_bf16(V, P, O[hh][dt], 0, 0, 0); }
            }
        }
        const bool act = (Lrun[0] >= SB_EXIT) || (Lrun[1] >= SB_EXIT);
        const unsigned long long bal = __ballot(act);
        if (lane == 0) flags[(i & 1) * 8 + wave] = (bal != 0ull) ? 1u : 0u;
        if (kt > 0) SB_STORE((i + 1) & 1);
        __syncthreads();
        unsigned any = 0;
#pragma unroll
        for (int w = 0; w < 8; ++w) any |= flags[(i & 1) * 8 + w];
        if (!any) break;
    }
#undef SB_LOAD
#undef SB_STORE
#pragma unroll
    for (int hh = 0; hh < 2; ++hh)
#pragma unroll
        for (int dt = 0; dt < 4; ++dt) { const f32x4 o = O[hh][dt]; v2u w; w.x = pk2(o.x, o.y); w.y = pk2(o.z, o.w);
            *(GAS v2u*)(YC + (size_t)tok * 256 + (2 * hp + hh) * 64 + 16 * dt + 4 * g) = w; }
    __syncthreads();
}

constexpr int SG_PITCH = 272;
__device__ __forceinline__ void sgu_unit(const Frame& F0, int layer, int chunk) {
    const Frame F = phase_frame(F0);
    const int lane = F.lane, wave = F.wave, q16 = lane & 15, g4 = lane >> 4;
    LAS unsigned char* L = F.lds;
    const bf16* GU = wsp<bf16>(F, PO_UB); const bf16* GV = wsp<bf16>(F, PO_VB); const bf16* WS = wsp<bf16>(F, WS_WS);
    bf16* YB = wsp<bf16>(F, WS_Y) + (size_t)1 * NTOK * 256;
    const int tok0 = chunk * 128;
    { const f32x4 lg = *(const f32x4*)(F.sgu_ln_g() + layer * 256 + 4 * lane), lbv = *(const f32x4*)(F.sgu_ln_b() + layer * 256 + 4 * lane);
      v2u rawv[16];
#pragma unroll
      for (int i = 0; i < 16; ++i) rawv[i] = *(const GAS v2u*)(GV + (size_t)(tok0 + 16 * wave + i) * 256 + 4 * lane);
#pragma unroll
      for (int i = 0; i < 16; ++i) { const int s = 16 * wave + i; const v2u raw = rawv[i];
          f32x4 v = {bf_lo(raw.x), bf_hi(raw.x), bf_lo(raw.y), bf_hi(raw.y)};
          const float mu = wave_sum((v.x + v.y) + (v.z + v.w), lane) * (1.0f / 256.0f); v = v - mu;
          const float var = wave_sum((v.x * v.x + v.y * v.y) + (v.z * v.z + v.w * v.w), lane) * (1.0f / 256.0f); const float rstd = 1.0f / sqrtf(var + EPS);
          const f32x4 o = v * rstd * lg + lbv;
          const unsigned p0 = pk2(o.x, o.y), p1 = pk2(o.z, o.w);
          *(LAS bf16*)(L + (4 * lane + 0) * SG_PITCH + 2 * s) = (bf16)(p0 & 0xffffu); *(LAS bf16*)(L + (4 * lane + 1) * SG_PITCH + 2 * s) = (bf16)(p0 >> 16);
          *(LAS bf16*)(L + (4 * lane + 2) * SG_PITCH + 2 * s) = (bf16)(p1 & 0xffffu); *(LAS bf16*)(L + (4 * lane + 3) * SG_PITCH + 2 * s) = (bf16)(p1 >> 16); } }
    __syncthreads();
    const int t0 = 16 * wave, nstep = (t0 + 15) / 32 + 1, tok = tok0 + t0 + q16;
    bf16x8 Bw[4][4]; v2u urv[4][4]; float bsv[4];
#pragma unroll
    for (int gI = 0; gI < 4; ++gI) {
#pragma unroll
        for (int j = 0; j < 4; ++j) Bw[gI][j] = __builtin_bit_cast(bf16x8, *(const GAS v4u*)(WS + ((size_t)gI * 128 + t0 + q16) * 128 + 32 * (j < nstep ? j : 0) + 8 * g4));
#pragma unroll
        for (int dt = 0; dt < 4; ++dt) urv[gI][dt] = *(const GAS v2u*)(GU + (size_t)tok * 256 + gI * 64 + 16 * dt + 4 * g4);
        bsv[gI] = F.b_spatial()[(layer * 4 + gI) * 128 + t0 + q16]; }
#pragma unroll
    for (int gI = 0; gI < 4; ++gI) {
        f32x4 acc[4];
#pragma unroll
        for (int dt = 0; dt < 4; ++dt) acc[dt] = (f32x4){0.f, 0.f, 0.f, 0.f};
#pragma unroll
        for (int j = 0; j < 4; ++j) if (j < nstep) {
#pragma unroll
            for (int dt = 0; dt < 4; ++dt) { const bf16x8 A = *(const LAS bf16x8*)(L + (gI * 64 + 16 * dt + q16) * SG_PITCH + (32 * j + 8 * g4) * 2);
                acc[dt] = __builtin_amdgcn_mfma_f32_16x16x32_bf16(A, Bw[gI][j], acc[dt], 0, 0, 0); }
        }
        const float bs = bsv[gI];
#pragma unroll
        for (int dt = 0; dt < 4; ++dt) { const int ch = gI * 64 + 16 * dt + 4 * g4; const v2u ur = urv[gI][dt];
            const f32x4 o = {bf_lo(ur.x) * (acc[dt].x + bs), bf_hi(ur.x) * (acc[dt].y + bs), bf_lo(ur.y) * (acc[dt].z + bs), bf_hi(ur.y) * (acc[dt].w + bs)};
            v2u w; w.x = pk2(o.x, o.y); w.y = pk2(o.z, o.w); *(GAS v2u*)(YB + (size_t)tok * 256 + ch) = w; }
    }
    __syncthreads();
}
__device__ __forceinline__ void conv_items(const Frame& F0, int layer) {
    const Frame F = phase_frame(F0);
    const bf16* BD = wsp<bf16>(F, PO_BD); const bf16* CD = wsp<bf16>(F, PO_CD); const bf16* XD = wsp<bf16>(F, PO_XD);
    bf16* YD = wsp<bf16>(F, WS_Y) + (size_t)3 * NTOK * 256;
    const float* cw = F.conv_w() + layer * 3 * 256;
    for (int it0 = F.bid * NTHR + F.tid; it0 < NTOK * 32; it0 += 2 * F.G * NTHR) {
        v4u cv[2][3], xv[2][3], bbv[2];
#pragma unroll
        for (int u = 0; u < 2; ++u) { const int it = it0 + u * F.G * NTHR, tok = it >> 5, c0 = (it & 31) * 8, s = tok & (SEQ - 1);
            bbv[u] = *(const GAS v4u*)(BD + (size_t)tok * 256 + c0);
#pragma unroll
            for (int tap = 0; tap < 3; ++tap) { const int d = 2 - tap; const int tk = (s - d >= 0) ? tok - d : tok;
                cv[u][tap] = *(const GAS v4u*)(CD + (size_t)tk * 256 + c0); xv[u][tap] = *(const GAS v4u*)(XD + (size_t)tk * 256 + c0); } }
#pragma unroll
        for (int u = 0; u < 2; ++u) { const int it = it0 + u * F.G * NTHR, tok = it >> 5, c0 = (it & 31) * 8, s = tok & (SEQ - 1);
            float y[8];
#pragma unroll
            for (int e = 0; e < 8; ++e) y[e] = 0.f;
#pragma unroll
            for (int tap = 0; tap < 3; ++tap) { const int d = 2 - tap; const float on = (s - d >= 0) ? 1.0f : 0.0f; const v4u c = cv[u][tap], x = xv[u][tap];
                const f32x4 w0 = *(const f32x4*)(cw + tap * 256 + c0) * on, w1 = *(const f32x4*)(cw + tap * 256 + c0 + 4) * on;
                y[0] += w0.x * (bf_lo(c.x) * bf_lo(x.x)); y[1] += w0.y * (bf_hi(c.x) * bf_hi(x.x)); y[2] += w0.z * (bf_lo(c.y) * bf_lo(x.y)); y[3] += w0.w * (bf_hi(c.y) * bf_hi(x.y));
                y[4] += w1.x * (bf_lo(c.z) * bf_lo(x.z)); y[5] += w1.y * (bf_hi(c.z) * bf_hi(x.z)); y[6] += w1.z * (bf_lo(c.w) * bf_lo(x.w)); y[7] += w1.w * (bf_hi(c.w) * bf_hi(x.w)); }
            const v4u bb = bbv[u];
            v4u o; o.x = pk2(y[0] * bf_lo(bb.x), y[1] * bf_hi(bb.x)); o.y = pk2(y[2] * bf_lo(bb.y), y[3] * bf_hi(bb.y)); o.z = pk2(y[4] * bf_lo(bb.z), y[5] * bf_hi(bb.z)); o.w = pk2(y[6] * bf_lo(bb.w), y[7] * bf_hi(bb.w));
            *(GAS v4u*)(YD + (size_t)tok * 256 + c0) = o; }
    }
}

constexpr size_t MI_TILE = MI_CNT + 32 * 1024;
__device__ __forceinline__ void router_phase(const Frame& F0, int layer) {
    const Frame F = phase_frame(F0); const float* x = layer == 0 ? F.x_in() : F.out; const bf16* dl = wsp<bf16>(F, WS_DELTA);
    const int lane = F.lane, wave = F.wave, tid = F.tid;
    LAS float* wT = (LAS float*)F.lds;
    LAS unsigned* cnt = (LAS unsigned*)(F.lds + TAB_OFF);
    const float* w_re = F.w_re() + (size_t)layer * 1024 * 32; const float* w_rg = F.w_rg() + (size_t)layer * 1024 * 4;
    for (int k0 = wave * 64; k0 < 1024; k0 += 512) {
#pragma unroll 8
        for (int e = 0; e < 32; ++e) { const int k = k0 + lane, pos = 256 * (2 * (k >> 9) + ((k >> 2) & 1)) + 4 * ((k & 511) >> 3) + (k & 3);
            wT[e * 1024 + pos] = w_re[(size_t)k * 32 + e]; } }
    if (tid < 32) cnt[tid] = 0u;
    f32x4 g2[4], wg[4][4];
#pragma unroll
    for (int j = 0; j < 4; ++j) { g2[j] = *(const f32x4*)(F.norm2_g() + layer * DM + rowcol(lane, j));
#pragma unroll
        for (int e = 0; e < 4; ++e) wg[j][e] = *(const f32x4*)(w_rg + (size_t)(rowcol(lane, j) + e) * 4); }
    const f32x4 brg = *(const f32x4*)(F.b_rg() + layer * 4);
    __syncthreads();
    int* EID = wsp<int>(F, MI_EID); float* EW = wsp<float>(F, MI_EW); bf16* H2 = wsp<bf16>(F, MO_H2);
    f32x4 vn[4]; v4u dn[2];
    { const size_t r0 = (size_t)(F.bid * 128 + wave * 16) * DM;
#pragma unroll
      for (int j = 0; j < 4; ++j) vn[j] = *(const GAS f32x4*)(x + r0 + rowcol(lane, j));
#pragma unroll
      for (int jp = 0; jp < 2; ++jp) dn[jp] = *(const GAS v4u*)(dl + r0 + 8 * lane + 512 * jp); }
    for (int i = 0; i < 16; ++i) {
        const int tok = F.bid * 128 + wave * 16 + i;
        f32x4 v[4]; float ss = 0.f;
#pragma unroll
        for (int j = 0; j < 4; ++j) v[j] = vn[j];
#pragma unroll
        for (int jp = 0; jp < 2; ++jp) add_bf16x8(v[2 * jp], v[2 * jp + 1], dn[jp]);
#pragma unroll
        for (int j = 0; j < 4; ++j) ss += (v[j].x * v[j].x + v[j].y * v[j].y) + (v[j].z * v[j].z + v[j].w * v[j].w);
        { const size_t r1 = (size_t)(tok + (i < 15 ? 1 : 0)) * DM;
#pragma unroll
          for (int j = 0; j < 4; ++j) vn[j] = *(const GAS f32x4*)(x + r1 + rowcol(lane, j));
#pragma unroll
          for (int jp = 0; jp < 2; ++jp) dn[jp] = *(const GAS v4u*)(dl + r1 + 8 * lane + 512 * jp); }
        const float rstd = 1.0f / sqrtf(wave_sum(ss, lane) * (1.0f / DM) + EPS);
#pragma unroll
        for (int j = 0; j < 4; ++j) v[j] = v[j] * rstd * g2[j];
#pragma unroll
        for (int jp = 0; jp < 2; ++jp) { v4u w; w.x = pk2(v[2 * jp].x, v[2 * jp].y); w.y = pk2(v[2 * jp].z, v[2 * jp].w); w.z = pk2(v[2 * jp + 1].x, v[2 * jp + 1].y); w.w = pk2(v[2 * jp + 1].z, v[2 * jp + 1].w);
            *(GAS v4u*)(H2 + (size_t)tok * DM + 8 * lane + 512 * jp) = w; }
        f32x4 gl = {0.f, 0.f, 0.f, 0.f};
#pragma unroll
        for (int j = 0; j < 4; ++j) { gl += wg[j][0] * v[j].x; gl += wg[j][1] * v[j].y; gl += wg[j][2] * v[j].z; gl += wg[j][3] * v[j].w; }
        gl.x = wave_sum(gl.x, lane) + brg.x; gl.y = wave_sum(gl.y, lane) + brg.y; gl.z = wave_sum(gl.z, lane) + brg.z; gl.w = wave_sum(gl.w, lane) + brg.w;
        int gs = 0; float gm = gl.x; if (gl.y > gm) { gm = gl.y; gs = 1; } if (gl.z > gm) { gm = gl.z; gs = 2; } if (gl.w > gm) { gm = gl.w; gs = 3; }
        const float grp_p = 1.0f / (__expf(gl.x - gm) + __expf(gl.y - gm) + __expf(gl.z - gm) + __expf(gl.w - gm));
        gs = __builtin_amdgcn_readfirstlane(gs);
        float el[8];
#pragma unroll
        for (int e = 0; e < 8; ++e) { const LAS float* wrow = wT + (gs * 8 + e) * 1024 + 4 * lane; float a = 0.f;
#pragma unroll
            for (int j = 0; j < 4; ++j) { const f32x4 w = *(const LAS f32x4*)(wrow + 256 * j); a += (w.x * v[j].x + w.y * v[j].y) + (w.z * v[j].z + w.w * v[j].w); }
            el[e] = wave_sum(a, lane) + F.b_re()[layer * 32 + gs * 8 + e]; }
        int j1 = 0; float l1 = el[0];
#pragma unroll
        for (int e = 1; e < 8; ++e) if (el[e] > l1) { l1 = el[e]; j1 = e; }
        int j2 = -1; float l2 = -__builtin_inff();
#pragma unroll
        for (int e = 0; e < 8; ++e) if (e != j1 && el[e] > l2) { l2 = el[e]; j2 = e; }
        const float e2 = __expf(l2 - l1), w1 = grp_p / (1.0f + e2), w2 = grp_p * e2 / (1.0f + e2);
        if (lane == 0) { EID[tok * 2] = gs * 8 + j1; EID[tok * 2 + 1] = gs * 8 + j2; EW[tok * 2] = w1; EW[tok * 2 + 1] = w2;
            __hip_atomic_fetch_add(&cnt[gs * 8 + j1], 1u, __ATOMIC_RELAXED, __HIP_MEMORY_SCOPE_WORKGROUP); __hip_atomic_fetch_add(&cnt[gs * 8 + j2], 1u, __ATOMIC_RELAXED, __HIP_MEMORY_SCOPE_WORKGROUP); }
    }
    __syncthreads();
    if (tid < 32) wsp<int>(F, MI_CNT)[F.bid * 32 + tid] = (int)cnt[tid];
    __syncthreads();
}
__device__ __forceinline__ void gather_phase(const Frame& F0, int layer) {
    const Frame F = phase_frame(F0); const float* x = F.out;
    const int lane = F.lane, wave = F.wave, tid = F.tid;
    LAS int* part = (LAS int*)F.lds;
    LAS int* tot = part + 1024; LAS int* bef = tot + 32; LAS int* pst = bef + 32;
    LAS int* eidl = pst + 40; LAS int* posl = eidl + 256;
    const int* CNT = wsp<int>(F, MI_CNT);
    { const int e = tid & 31, p = tid >> 5; int st = 0, sb = 0;
      for (int w = p * 16; w < p * 16 + 16; ++w) { const int c = CNT[w * 32 + e]; st += c; sb += (w < F.bid) ? c : 0; }
      part[p * 32 + e] = st; part[512 + p * 32 + e] = sb; }
    if (tid < 256) eidl[tid] = wsp<int>(F, MI_EID)[F.bid * 256 + tid];
    __syncthreads();
    if (tid < 32) { int st = 0, sb = 0; for (int p = 0; p < 16; ++p) { st += part[p * 32 + tid]; sb += part[512 + p * 32 + tid]; } tot[tid] = st; bef[tid] = sb; }
    __syncthreads();
    if (tid == 0) { int a = 0; for (int e = 0; e < 32; ++e) { pst[e] = a; a += (tot[e] + 255) & ~255; } pst[32] = a; }
    __syncthreads();
    if (tid < 256) { const int e = eidl[tid]; int rank = 0; for (int i = 0; i < tid; ++i) rank += (eidl[i] == e) ? 1 : 0; posl[tid] = pst[e] + bef[e] + rank; }
    __syncthreads();
    int* RTOK = wsp<int>(F, MI_RTOK); float* RW = wsp<float>(F, MI_RW);
    const float* EW = wsp<float>(F, MI_EW);
    if (tid < 256) { const int p = posl[tid], tok = F.bid * 128 + (tid >> 1); RTOK[p] = tok * 2 + (tid & 1); RW[p] = EW[F.bid * 256 + tid]; }
    if (F.bid < 32) { const int e = F.bid; for (int r = pst[e] + tot[e] + tid; r < pst[e + 1]; r += NTHR) { RTOK[r] = -1; RW[r] = 0.f; } }
    if (F.bid == 32) { int* TILE = wsp<int>(F, MI_TILE); const int ntile = pst[32] >> 8;
        for (int pm = tid; pm < ntile; pm += NTHR) { int e = 0; for (int k = 1; k < 32; ++k) e += (pst[k] <= pm * 256) ? 1 : 0; TILE[pm] = e; }
        if (tid == 0) TILE[511] = ntile; }
    __syncthreads();
}

constexpr int PH_PER_LAYER = 11, PH_FINAL = DEPTH * PH_PER_LAYER, PH_TOTAL = PH_FINAL + 1;
struct Args { const void* in[20]; float* out; unsigned char* ws; int ph_lo, ph_hi, li, pad; };
__global__ void __launch_bounds__(NTHR, 2) hybrid_fwd(Args args) {
    extern __shared__ __attribute__((aligned(16))) unsigned char lds[];
    Frame F;
    F.lds = (LAS unsigned char*)lds; F.MISC = (volatile LAS unsigned*)(F.lds + MISC_OFF);
    F.wave = __builtin_amdgcn_readfirstlane((int)threadIdx.x >> 6); F.tid = 0; F.lane = 0; F.G = gridDim.x; F.bid = blockIdx.x;
    F.ws = args.ws; F.out = args.out; F.kin = (const CAS4 inptr_t*)__builtin_amdgcn_kernarg_segment_ptr();
    { const Frame FL = phase_frame(F); for (int u = FL.tid; u < 64; u += NTHR) ((LAS unsigned*)(F.lds + MISC_OFF))[u] = 0u; }
    __syncthreads();
    const int lo = args.ph_lo, hi = args.ph_hi;
    const bool use_bar = (hi - lo) > 1;
    unsigned* const barw = (unsigned*)(F.ws + WS_CTL) + CW_BAR + args.li * XCD_BAR_WORDS;
    XcdBarrier bar; bar.bar = barw; bar.x = 0; bar.st = nullptr;
    bar.wid = F.wave;
    if (use_bar) bar = xcd_barrier_post(barw, F.MISC + 8, F.wave);
#ifndef PH_MASK
#define PH_MASK 0xffffffu
#endif
#define INC(c, k) (((PH_MASK >> (c)) & 1u) && lo <= (k) && (k) < hi)
#ifndef PROBE_DUP
#define PROBE_DUP -1
#endif
#define DUPB(c) if (PROBE_DUP == (c) && layer == 0) xcd_barrier(bar)
#define SEAM(k) do { if (lo <= (k) && (k) + 1 < hi) xcd_barrier(bar); } while (0)
    PG8_LAS unsigned char* ring = (PG8_LAS unsigned char*)lds;
    const int cx = (F.bid & 7) * (F.G >> 3) + (F.bid >> 3);

#pragma unroll 1
    for (int layer = 0; layer < DEPTH; ++layer) {
        const int pb = layer * PH_PER_LAYER;
        if (INC(0, pb + 0)) {
            l0_weights(F, layer);
            if (layer == 0) { l0_rope(F); rms_rows<0, false>(F, 0); }
            else rms_rows<1, false>(F, layer);
#if PROBE_DUP == 0
            if (layer == 0) { xcd_barrier(bar); l0_weights(F, layer); l0_rope(F); rms_rows<0, false>(F, 0); }
#endif
        }
        SEAM(pb + 0);
        if (INC(1, pb + 1)) {
            {
            Frame FL = F; FL.ws = launder_s(F.ws);
            { pg8::Gemm g{wsp<bf16>(FL, WS_H), wsp<bf16>(FL, WS_WP), NTOK, 2560, 1024}; pg8::StaticOrder S; S.init(NTOK, 2560, F.G, F.bid); EpiProj E{FL.ws};
              pg8::gemm_phase<EpiProj, pg8::StaticOrder, true, true>(ring, g, S, E, F.wave); }
            FL.ws = launder_s(F.ws);
            { pg8::Gemm g{wsp<bf16>(FL, WS_WV), wsp<bf16>(FL, WS_H), 512, NTOK, 1024}; pg8::StaticOrder S; S.init(512, NTOK, F.G, F.bid); EpiStoreBf16 E{wsp<bf16>(FL, PO_VT), NTOK, 0x7fffffff};
              pg8::gemm_phase<EpiStoreBf16, pg8::StaticOrder, true, true>(ring, g, S, E, F.wave); }
            }
#if PROBE_DUP == 1
            if (layer == 0) { xcd_barrier(bar);
            Frame FL = F; FL.ws = launder_s(F.ws);
            { pg8::Gemm g{wsp<bf16>(FL, WS_H), wsp<bf16>(FL, WS_WP), NTOK, 2560, 1024}; pg8::StaticOrder S; S.init(NTOK, 2560, F.G, F.bid); EpiProj E{FL.ws};
              pg8::gemm_phase<EpiProj, pg8::StaticOrder, true, true>(ring, g, S, E, F.wave); }
            FL.ws = launder_s(F.ws);
            { pg8::Gemm g{wsp<bf16>(FL, WS_WV), wsp<bf16>(FL, WS_H), 512, NTOK, 1024}; pg8::StaticOrder S; S.init(512, NTOK, F.G, F.bid); EpiStoreBf16 E{wsp<bf16>(FL, PO_VT), NTOK, 0x7fffffff};
              pg8::gemm_phase<EpiStoreBf16, pg8::StaticOrder, true, true>(ring, g, S, E, F.wave); }
            }
#endif
        }
        SEAM(pb + 1);
        if (INC(2, pb + 2)) {
            for (int p0 = F.bid; p0 < 256; p0 += F.G) { const int p = ((p0 & 7) << 5) | (p0 >> 3), b = p >> 6, j = p & 63;
_Pragma("unroll 1") for (int k = 0; k < 2; ++k) { topk_subunit(F, b, 2 * j + k); topk_subunit(F, b, 255 - 2 * j - k); } }
#if PROBE_DUP == 2
            if (layer == 0) { xcd_barrier(bar); for (int p0 = F.bid; p0 < 256; p0 += F.G) { const int p = ((p0 & 7) << 5) | (p0 >> 3), b = p >> 6, j = p & 63;
_Pragma("unroll 1") for (int k = 0; k < 2; ++k) { topk_subunit(F, b, 2 * j + k); topk_subunit(F, b, 255 - 2 * j - k); } } }
#endif
        }
        if (lo <= pb + 2 && pb + 3 < hi) { VM_WAIT(); __syncthreads(); __builtin_amdgcn_fence(__ATOMIC_ACQUIRE, "agent"); VM_WAIT(); __syncthreads(); }
        if (INC(3, pb + 3)) {
            for (int u = F.bid; u < 512; u += F.G) sb_subunit(F, u >> 7, u & 127);
            for (int u = F.bid; u < 256; u += F.G) sgu_unit(F, layer, u);
            conv_items(F, layer);
#if PROBE_DUP == 12
            if (layer == 0) { xcd_barrier(bar); for (int u = F.bid; u < 512; u += F.G) sb_subunit(F, u >> 7, u & 127);
                for (int u = F.bid; u < 256; u += F.G) sgu_unit(F, layer, u);
                conv_items(F, layer); }
#endif
            for (int p0 = F.bid; p0 < 256; p0 += F.G) { const int p = ((p0 & 7) << 5) | (p0 >> 3), b = p >> 6, j = p & 63; dsa_subunit(F, b, j); dsa_subunit(F, b, 127 - j); }
#if PROBE_DUP == 3
            if (layer == 0) { xcd_barrier(bar); for (int p0 = F.bid; p0 < 256; p0 += F.G) { const int p = ((p0 & 7) << 5) | (p0 >> 3), b = p >> 6, j = p & 63; dsa_subunit(F, b, j); dsa_subunit(F, b, 127 - j); }     }
#endif
        }
        SEAM(pb + 3);
        if (INC(4, pb + 4)) { { Frame FL = F; FL.ws = launder_s(F.ws); pg8::Gemm g{wsp<bf16>(FL, WS_Y), wsp<bf16>(FL, WS_WB), 4 * NTOK, 4096, 256}; POrder S{F.G, cx}; EpiP E{wsp<unsigned char>(FL, WS_BIG)};
            pg8::gemm_phase<EpiP, POrder, true, true>(ring, g, S, E, F.wave); }
#if PROBE_DUP == 4
            if (layer == 0) { xcd_barrier(bar); { Frame FL = F; FL.ws = launder_s(F.ws); pg8::Gemm g{wsp<bf16>(FL, WS_Y), wsp<bf16>(FL, WS_WB), 4 * NTOK, 4096, 256}; POrder S{F.G, cx}; EpiP E{wsp<unsigned char>(FL, WS_BIG)};
            pg8::gemm_phase<EpiP, POrder, true, true>(ring, g, S, E, F.wave); } }
#endif
        }
        SEAM(pb + 4);
        if (INC(5, pb + 5)) { { Frame FL = F; FL.ws = launder_s(F.ws); pg8::Gemm g{wsp<bf16>(FL, WS_H), wsp<bf16>(FL, WS_WG), NTOK, 4096, 1024}; pg8::StaticOrder S; S.init(NTOK, 4096, F.G, F.bid); EpiGate E{wsp<unsigned char>(FL, WS_BIG), wsp<bf16>(FL, WS_Y)};
            pg8::gemm_phase<EpiGate, pg8::StaticOrder, true, true>(ring, g, S, E, F.wave); }
#if PROBE_DUP == 5
            if (layer == 0) { xcd_barrier(bar); { Frame FL = F; FL.ws = launder_s(F.ws); pg8::Gemm g{wsp<bf16>(FL, WS_H), wsp<bf16>(FL, WS_WG), NTOK, 4096, 1024}; pg8::StaticOrder S; S.init(NTOK, 4096, F.G, F.bid); EpiGate E{wsp<unsigned char>(FL, WS_BIG), wsp<bf16>(FL, WS_Y)};
            pg8::gemm_phase<EpiGate, pg8::StaticOrder, true, true>(ring, g, S, E, F.wave); } }
#endif
        }
        SEAM(pb + 5);
        if (INC(6, pb + 6)) { { Frame FL = F; FL.ws = launder_s(F.ws); pg8::Gemm g{wsp<bf16>(FL, WS_Y), wsp<bf16>(FL, WS_WO), NTOK, 1024, 1024}; pg8::StaticOrder S; S.init(NTOK, 1024, F.G, F.bid); EpiStoreBf16 E{wsp<bf16>(FL, WS_DELTA), 1024, 0x7fffffff};
            pg8::gemm_phase<EpiStoreBf16, pg8::StaticOrder, true, true>(ring, g, S, E, F.wave); }
#if PROBE_DUP == 6
            if (layer == 0) { xcd_barrier(bar); { Frame FL = F; FL.ws = launder_s(F.ws); pg8::Gemm g{wsp<bf16>(FL, WS_Y), wsp<bf16>(FL, WS_WO), NTOK, 1024, 1024}; pg8::StaticOrder S; S.init(NTOK, 1024, F.G, F.bid); EpiStoreBf16 E{wsp<bf16>(FL, WS_DELTA), 1024, 0x7fffffff};
            pg8::gemm_phase<EpiStoreBf16, pg8::StaticOrder, true, true>(ring, g, S, E, F.wave); } }
#endif
        }
        SEAM(pb + 6);
        if (INC(7, pb + 7)) { router_phase(F, layer);
#if PROBE_DUP == 7
            if (layer == 0) { xcd_barrier(bar); router_phase(F, layer); }
#endif
        }
        SEAM(pb + 7);
        if (INC(8, pb + 8)) { gather_phase(F, layer);
#if PROBE_DUP == 8
            if (layer == 0) { xcd_barrier(bar); gather_phase(F, layer); }
#endif
        }
        SEAM(pb + 8);
        if (INC(9, pb + 9) || INC(10, pb + 10)) {
            LAS int* tile_e = (LAS int*)(F.lds + TAB_OFF); const int* TILE = wsp<int>(F, MI_TILE); const int ntile = __builtin_amdgcn_readfirstlane(TILE[511]);
            LAS int* rowtab = (LAS int*)(F.lds + TAB_OFF + 4096);
            { const Frame FT = phase_frame(F); for (int i = FT.tid; i < ntile; i += NTHR) tile_e[i] = TILE[i];
              const int* RTOK = wsp<int>(FT, MI_RTOK);
              for (int q = FT.tid; q < 4 * 256; q += NTHR) { const int L = (q >> 8) * F.G + cx; int v = 0; if (L < ntile * 2) { const int r = RTOK[(L >> 1) * 256 + (q & 255)]; v = r < 0 ? 0 : (r >> 1); } rowtab[q] = v; } }
            __syncthreads();
            unsigned* const tcnt = (unsigned*)(F.ws + WS_CTL) + CW_TCNT + layer * TCNT_LAYER; unsigned* const tmo10 = (unsigned*)(F.ws + WS_CTL) + CW_TMO;
            const int r9 = (2 * ntile) % F.G, nl10 = F.G - r9, cv10 = cx >= r9 ? cx - r9 : nl10 + cx;
            if (INC(9, pb + 9)) { { Frame FL = F; FL.ws = launder_s(F.ws); pg8::Gemm g{wsp<bf16>(FL, MO_H2), wsp<bf16>(FL, WS_WGU), NTOK, 512 * NEXP, 1024}; Moe9Order S{F.G, cx, ntile, tile_e, tcnt}; EpiGU E{wsp<float>(FL, MI_RW), wsp<bf16>(FL, MO_HH)};
                pg8::gemm_phase<EpiGU, Moe9Order, true, true, true>(ring, g, S, E, F.wave, (const PG8_LAS int*)rowtab); }
#if PROBE_DUP == 9
            if (layer == 0) { xcd_barrier(bar); { Frame FL = F; FL.ws = launder_s(F.ws); pg8::Gemm g{wsp<bf16>(FL, MO_H2), wsp<bf16>(FL, WS_WGU), NTOK, 512 * NEXP, 1024}; Moe9Order S{F.G, cx, ntile, tile_e, tcnt}; EpiGU E{wsp<float>(FL, MI_RW), wsp<bf16>(FL, MO_HH)};
                pg8::gemm_phase<EpiGU, Moe9Order, true, true, true>(ring, g, S, E, F.wave, (const PG8_LAS int*)rowtab); } }
#endif
        }
            if (INC(10, pb + 10)) { { Frame FL = F; FL.ws = launder_s(F.ws); pg8::Gemm g{wsp<bf16>(FL, MO_HH), wsp<bf16>(FL, WS_WD), MOE_MAXROWS, 1024 * NEXP, 256}; Moe10Order S{F.G, cv10, nl10, ntile, tile_e, tcnt, tmo10, F.wave}; EpiDown E{wsp<int>(FL, MI_RTOK), wsp<bf16>(FL, WS_Y), wsp<bf16>(FL, WS_H)};
                pg8::gemm_phase<EpiDown, Moe10Order, true, true>(ring, g, S, E, F.wave); }
#if PROBE_DUP == 10
            if (layer == 0) { xcd_barrier(bar); { Frame FL = F; FL.ws = launder_s(F.ws); pg8::Gemm g{wsp<bf16>(FL, MO_HH), wsp<bf16>(FL, WS_WD), MOE_MAXROWS, 1024 * NEXP, 256}; Moe10Order S{F.G, cv10, nl10, ntile, tile_e, tcnt, tmo10, F.wave}; EpiDown E{wsp<int>(FL, MI_RTOK), wsp<bf16>(FL, WS_Y), wsp<bf16>(FL, WS_H)};
                pg8::gemm_phase<EpiDown, Moe10Order, true, true>(ring, g, S, E, F.wave); } }
#endif
        }
        }
        SEAM(pb + 10);
    }
    if (INC(11, PH_FINAL)) rms_rows<1, true>(F, 0);
#undef INC
#undef SEAM
}

#ifndef N_CUTS
#define N_CUTS 0
#endif
#ifndef PROBE_SPLIT
#define PROBE_SPLIT -1
#endif
extern "C" void kernel_launch(void* const* d_in, const int* in_sizes, int n_in, void* d_out, int out_size, void* d_ws, size_t ws_size, hipStream_t stream) {
    static int grid = 0;
    if (grid == 0) {
        if (n_in != 20 || out_size != NTOK * DM || ws_size < WS_END) { fprintf(stderr, "kernel_launch: unexpected shapes (n_in %d out %d ws %zu)\n", n_in, out_size, ws_size); grid = -1; return; }
        int dev = 0, cus = 0, per_cu = 0;
        if (hipGetDevice(&dev) != hipSuccess || hipDeviceGetAttribute(&cus, hipDeviceAttributeMultiprocessorCount, dev) != hipSuccess) { grid = -1; return; }
        if (hipFuncSetAttribute((const void*)hybrid_fwd, hipFuncAttributeMaxDynamicSharedMemorySize, LDS_BYTES) != hipSuccess) { fprintf(stderr, "kernel_launch: hipFuncSetAttribute failed\n"); grid = -1; return; }
        if (hipOccupancyMaxActiveBlocksPerMultiprocessor(&per_cu, (const void*)hybrid_fwd, NTHR, LDS_BYTES) != hipSuccess || per_cu < 1) fprintf(stderr, "kernel_launch: occupancy query reports %d\n", per_cu);
        (void)hipGetLastError();
        grid = cus;
        if (grid != 256) { fprintf(stderr, "kernel_launch: built for 256 CUs, found %d\n", cus); grid = -1; return; }
    }
    if (grid < 0) return;
    if (hipMemsetAsync((char*)d_ws + WS_CTL, 0, CTL_ZERO_BYTES, stream) != hipSuccess) return;
    Args a{};
    for (int i = 0; i < 20; ++i) a.in[i] = d_in[i];
    a.out = (float*)d_out; a.ws = (unsigned char*)d_ws;
#if N_CUTS == 0 && PROBE_SPLIT < 0
    a.ph_lo = 0; a.ph_hi = PH_TOTAL; a.li = 0;
    hipLaunchKernelGGL(hybrid_fwd, dim3(grid), dim3(NTHR), LDS_BYTES, stream, a);
#elif N_CUTS == 0
    a.ph_lo = 0; a.ph_hi = PROBE_SPLIT + 1; a.li = 0; hipLaunchKernelGGL(hybrid_fwd, dim3(grid), dim3(NTHR), LDS_BYTES, stream, a);
    a.ph_lo = PROBE_SPLIT; a.ph_hi = PH_TOTAL; a.li = 1; hipLaunchKernelGGL(hybrid_fwd, dim3(grid), dim3(NTHR), LDS_BYTES, stream, a);
#else
    for (int p = 0; p < PH_TOTAL; ++p) { a.ph_lo = p; a.ph_hi = p + 1; a.li = 0; hipLaunchKernelGGL(hybrid_fwd, dim3(grid), dim3(NTHR), LDS_BYTES, stream, a); }
#endif
}
```

```cpp
#include <hip/hip_runtime.h>
#include <cstdio>
#include <cstdint>
#define GAS __attribute__((address_space(1)))
#define LAS __attribute__((address_space(3)))
namespace pg8 {
#define PG8_LAS __attribute__((address_space(3)))
typedef unsigned short bf16_t;
typedef short bf16x8 __attribute__((ext_vector_type(8)));
typedef float f32x4 __attribute__((ext_vector_type(4)));
typedef unsigned u32x4 __attribute__((ext_vector_type(4)));
constexpr int BM = 256, BK = 64, HALF = 128, HTB = HALF * BK * 2  , STAGE_BYTES = 8 * HTB, NXCD = 8, WGM = 8;

__host__ __device__ __forceinline__ int lds_byte(int r, int c) { const int st = (r >> 4) * 2 + (c >> 5), rr = r & 15, cc = c & 31, ob = rr * 64 + cc * 2; return st * 1024 + (ob ^ (((ob >> 9) & 1) << 5)); }
__host__ __device__ __forceinline__ void stage_rc(int b, int& R, int& C) { const int st = b / 1024, sb = b % 1024, swz = sb ^ (((sb >> 9) & 1) << 5); R = (st >> 1) * 16 + swz / 64; C = (st & 1) * 32 + (swz % 64) / 2; }
__host__ __device__ __forceinline__ int perm32(int rho) { const int n = rho >> 4, i = rho & 15; return 8 * (i >> 2) + 4 * n + (i & 3); }

__device__ __forceinline__ f32x4 pg8_zero4() { double a, b; asm volatile("v_mov_b64 %0, 0" : "=v"(a)); asm volatile("v_mov_b64 %0, 0" : "=v"(b)); struct P2 { double a, b; } p{a, b}; return __builtin_bit_cast(f32x4, p); }
struct Unit { int pm, pn; };
struct Gemm { const bf16_t* A; const bf16_t* Bt; int M, N, K; };

struct StaticOrder {
    int nM, nN, nwg, G, c;
    __host__ __device__ void init(int M, int N, int G_, int c_) { nM = M / BM; nN = N / BM; nwg = nM * nN; G = G_; c = c_; }
    __host__ __device__ bool next(int i, Unit& u) const {
        const long L = (long)i * G + c; if (L >= nwg) return false;
        int wgid = (int)L; { const int q = nwg / NXCD, r = nwg % NXCD, xcd = wgid % NXCD, off = wgid / NXCD; wgid = (xcd < r ? xcd * (q + 1) : r * (q + 1) + (xcd - r) * q) + off; }
        const int nig = WGM * nN, gid = wgid / nig, fm = gid * WGM, gsz = (nM - fm) < WGM ? (nM - fm) : WGM;
        u.pm = fm + ((wgid % nig) % gsz); u.pn = (wgid % nig) / gsz; return true;
    }
    __device__ __forceinline__ unsigned a_peek(const Unit&) const { return 0u; }
    __device__ __forceinline__ void a_ready(const Unit&, unsigned = 0u) const {}
    __device__ __forceinline__ void done(const Unit&) const {}
};

typedef __bf16 bf16x2_native __attribute__((ext_vector_type(2)));
__device__ __forceinline__ unsigned cvt_pk_bf16(float lo, float hi) { const float __attribute__((ext_vector_type(2))) v = {lo, hi}; return __builtin_bit_cast(unsigned, __builtin_convertvector(v, bf16x2_native)); }
typedef float f32x2 __attribute__((ext_vector_type(2)));
template <class Epi, class Sched, bool ALIGN_EPI = false, bool SP2 = false, bool GATHER = false>
__device__ __forceinline__ void gemm_phase(PG8_LAS unsigned char* lds, const Gemm g, const Sched& S, const Epi& E, int wid_in, const PG8_LAS int* rowtab = nullptr) {
    static_assert(!GATHER || SP2, "GATHER is implemented for the SP2 loop only");
    int lane_; asm volatile("v_mbcnt_lo_u32_b32 %0, -1, 0\n\tv_mbcnt_hi_u32_b32 %0, -1, %0" : "=v"(lane_)); int wid_ = wid_in; asm volatile("" : "+s"(wid_));
    const int wid = wid_, lane = lane_, tid = wid * 64 + lane, wr = wid >> 2, wc = wid & 3, fr = lane & 15, fq = lane >> 4;
    const int K = g.K, nt = K / BK;
    unsigned voffA[2], voffB[2];
#pragma unroll
    for (int i = 0; i < 2; ++i) { int R, C; stage_rc(tid * 16 + i * 8192, R, C); const int Rb = Epi::PERM ? ((R & ~31) + perm32(R & 31)) : R;
        voffA[i] = (unsigned)(R * K + C) * 2u; voffB[i] = (unsigned)(Rb * K + C) * 2u; }
    const size_t kstep = (size_t)(BK * 2);
    const size_t hstep = (size_t)HALF * K * 2;
    const size_t tstep = 2 * hstep;
    const unsigned ldsw = (unsigned)wid * 1024u;
    const int aoff = lds_byte(wr * 64 + fr, fq * 8), boff = lds_byte(wc * 32 + fr, fq * 8);
#define PG8_SA(b, h) (((b) * 2 + (h)) * HTB)
#define PG8_SB(b, h) ((4 + (b) * 2 + (h)) * HTB)
#define PG8_STAGE(bufoff, gbase, voff) do { _Pragma("unroll") for (int _i = 0; _i < 2; ++_i) \
        __builtin_amdgcn_global_load_lds((const unsigned*)((const char*)(gbase) + (voff)[_i]), (PG8_LAS unsigned*)(lds + (bufoff) + ldsw + _i * 8192), 16, 0, 0); } while (0)
#define PG8_STAGE_A(bufoff, gbase, h, goff) do { if constexpr (GATHER) PG8_STAGE(bufoff, gbase, (goff)[h]); else PG8_STAGE(bufoff, (gbase) + (h) * hstep, voffA); } while (0)
#define PG8_ROWS(slot, o) do { _Pragma("unroll") for (int _h = 0; _h < 2; ++_h) _Pragma("unroll") for (int _i = 0; _i < 2; ++_i) { unsigned _v = voffA[_i]; asm volatile("" : "+v"(_v));   const unsigned _R = _v / (2u * (unsigned)K), _c2 = _v - _R * (2u * (unsigned)K); \
        (o)[_h][_i] = (unsigned)rowtab[(slot) * 256 + _h * 128 + (int)_R] * (2u * (unsigned)K) + _c2; } } while (0)
#define PG8_LDA(dst, b, h) do { _Pragma("unroll") for (int m = 0; m < 4; ++m) _Pragma("unroll") for (int k = 0; k < 2; ++k) dst[m][k] = *(const PG8_LAS bf16x8*)(lds + PG8_SA(b, h) + aoff + m * 2048 + k * 1024); } while (0)
#define PG8_LDB(dst, b, h) do { _Pragma("unroll") for (int n = 0; n < 2; ++n) _Pragma("unroll") for (int k = 0; k < 2; ++k) dst[n][k] = *(const PG8_LAS bf16x8*)(lds + PG8_SB(b, h) + boff + n * 2048 + k * 1024); } while (0)
#define PG8_MMA(ai, bj, At, Bt) do { __builtin_amdgcn_s_setprio(1); _Pragma("unroll") for (int m = 0; m < 4; ++m) _Pragma("unroll") for (int n = 0; n < 2; ++n) _Pragma("unroll") for (int k = 0; k < 2; ++k) \
        acc[ai][bj][m][n] = __builtin_amdgcn_mfma_f32_16x16x32_bf16(Bt[n][k], At[m][k], acc[ai][bj][m][n], 0, 0, 0); __builtin_amdgcn_s_setprio(0); } while (0)
#define PG8_WAIT_V(n) asm volatile("s_waitcnt vmcnt(" #n ")" ::: "memory")
#define PG8_WAIT_L(n) asm volatile("s_waitcnt lgkmcnt(" #n ")" ::: "memory")
#define PG8_BAR __builtin_amdgcn_s_barrier()
#define PG8_SCHED __builtin_amdgcn_sched_barrier(0)
    Unit cur, nxt; int ui = 0;
    if (!S.next(0, cur)) return;
    f32x4 acc[2][2][4][2];
#pragma unroll
    for (int a = 0; a < 2; ++a)
#pragma unroll
        for (int b = 0; b < 2; ++b)
#pragma unroll
            for (int m = 0; m < 4; ++m)
#pragma unroll
                for (int n = 0; n < 2; ++n) acc[a][b][m][n] = pg8_zero4();
    bf16x8 At[4][2], B0[2][2], B1[2][2];
    const char* cA = GATHER ? (const char*)g.A : (const char*)g.A + (size_t)cur.pm * tstep; const char* cB = (const char*)g.Bt + (size_t)cur.pn * tstep;
    unsigned gC[2][2] = {{0u, 0u}, {0u, 0u}};
    if constexpr (GATHER) PG8_ROWS(0, gC);
    S.a_ready(cur);
    if constexpr (SP2) {
        PG8_STAGE(PG8_SB(0, 0), cB, voffB); PG8_STAGE(PG8_SB(0, 1), cB + hstep, voffB); PG8_STAGE_A(PG8_SA(0, 0), cA, 0, gC); PG8_STAGE_A(PG8_SA(0, 1), cA, 1, gC);
        if (wr == 1) PG8_BAR;
        PG8_WAIT_V(2); PG8_BAR;
        PG8_STAGE(PG8_SB(1, 0), cB + kstep, voffB); PG8_STAGE_A(PG8_SA(1, 0), cA + kstep, 0, gC); PG8_STAGE(PG8_SB(1, 1), cB + hstep + kstep, voffB);
        PG8_WAIT_V(6); PG8_BAR;
    } else {
        PG8_STAGE(PG8_SB(0, 0), cB, voffB); PG8_STAGE(PG8_SA(0, 0), cA, voffA); PG8_STAGE(PG8_SB(0, 1), cB + hstep, voffB); PG8_STAGE(PG8_SA(0, 1), cA + hstep, voffA);
        if (wr == 1) PG8_BAR;
        PG8_WAIT_V(4); PG8_BAR;
        PG8_STAGE(PG8_SB(1, 0), cB + kstep, voffB); PG8_STAGE(PG8_SA(1, 0), cA + kstep, voffA); PG8_STAGE(PG8_SB(1, 1), cB + hstep + kstep, voffB);
        PG8_WAIT_V(6); PG8_BAR;
    }
    for (;;) {
        const bool has_next = S.next(ui + 1, nxt);
        const unsigned pk = has_next ? S.a_peek(nxt) : 0u;
        const char* nA = (has_next && !GATHER) ? (const char*)g.A + (size_t)nxt.pm * tstep : cA; const char* nB = has_next ? (const char*)g.Bt + (size_t)nxt.pn * tstep : cB;
#pragma unroll 1
        for (int t = 0; t < nt; t += 2) {
            const bool last = (t == nt - 2);
            const char* a1 = cA + (size_t)(t + 1) * kstep;
            const char* a2 = last ? nA : cA + (size_t)(t + 2) * kstep; const char* b2 = last ? nB : cB + (size_t)(t + 2) * kstep;
            const char* a3 = a2 + kstep; const char* b3 = b2 + kstep;
            if (last && has_next) S.a_ready(nxt, pk);
            unsigned gS[2][2];
#pragma unroll
            for (int _h = 0; _h < 2; ++_h)
#pragma unroll
                for (int _i = 0; _i < 2; ++_i) gS[_h][_i] = gC[_h][_i];
            if constexpr (GATHER) { if (last && has_next) PG8_ROWS(ui + 1, gS); }
            if constexpr (SP2) {
            PG8_LDB(B0, 0, 0); PG8_LDB(B1, 0, 1); PG8_SCHED; PG8_LDA(At, 0, 0); PG8_STAGE_A(PG8_SA(1, 1), a1, 1, gC);
            PG8_WAIT_V(8); PG8_WAIT_L(0); PG8_BAR; PG8_MMA(0, 0, At, B0); PG8_MMA(0, 1, At, B1); PG8_BAR; PG8_SCHED;
            PG8_LDA(At, 0, 1); PG8_STAGE(PG8_SB(0, 0), b2, voffB); PG8_STAGE(PG8_SB(0, 1), b2 + hstep, voffB); PG8_STAGE_A(PG8_SA(0, 0), a2, 0, gS);
            PG8_WAIT_V(8); PG8_WAIT_L(0); PG8_BAR; PG8_MMA(1, 0, At, B0); PG8_MMA(1, 1, At, B1); PG8_BAR; PG8_SCHED;
            PG8_LDB(B0, 1, 0); PG8_LDB(B1, 1, 1); PG8_SCHED; PG8_LDA(At, 1, 0); PG8_STAGE_A(PG8_SA(0, 1), a2, 1, gS);
            PG8_WAIT_V(8); PG8_WAIT_L(0); PG8_BAR; PG8_MMA(0, 0, At, B0); PG8_MMA(0, 1, At, B1); PG8_BAR; PG8_SCHED;
            PG8_LDA(At, 1, 1); PG8_STAGE(PG8_SB(1, 0), b3, voffB); PG8_STAGE(PG8_SB(1, 1), b3 + hstep, voffB); PG8_STAGE_A(PG8_SA(1, 0), a3, 0, gS);
            PG8_WAIT_V(8); PG8_WAIT_L(0); PG8_BAR; PG8_MMA(1, 0, At, B0); PG8_MMA(1, 1, At, B1); PG8_BAR; PG8_SCHED;
            } else {
            PG8_LDB(B0, 0, 0); PG8_SCHED; PG8_LDA(At, 0, 0); PG8_STAGE(PG8_SA(1, 1), a1 + hstep, voffA);
            PG8_WAIT_L(8); PG8_BAR; PG8_WAIT_L(0); PG8_MMA(0, 0, At, B0); PG8_BAR; PG8_SCHED;
            PG8_LDB(B1, 0, 1); PG8_STAGE(PG8_SB(0, 0), b2, voffB);
            PG8_BAR; PG8_WAIT_L(0); PG8_MMA(0, 1, At, B1); PG8_BAR;
            PG8_LDA(At, 0, 1); PG8_STAGE(PG8_SA(0, 0), a2, voffA);
            PG8_BAR; PG8_WAIT_L(0); PG8_MMA(1, 0, At, B0); PG8_BAR; PG8_SCHED;
            PG8_STAGE(PG8_SB(0, 1), b2 + hstep, voffB);
            PG8_WAIT_V(6); PG8_BAR; PG8_MMA(1, 1, At, B1); PG8_BAR;
            PG8_LDB(B0, 1, 0); PG8_SCHED; PG8_LDA(At, 1, 0); PG8_STAGE(PG8_SA(0, 1), a2 + hstep, voffA);
            PG8_WAIT_L(8); PG8_BAR; PG8_WAIT_L(0); PG8_MMA(0, 0, At, B0); PG8_BAR; PG8_SCHED;
            PG8_LDB(B1, 1, 1); PG8_STAGE(PG8_SB(1, 0), b3, voffB);
            PG8_BAR; PG8_WAIT_L(0); PG8_MMA(0, 1, At, B1); PG8_BAR;
            PG8_LDA(At, 1, 1); PG8_STAGE(PG8_SA(1, 0), a3, voffA);
            PG8_BAR; PG8_WAIT_L(0); PG8_MMA(1, 0, At, B0); PG8_BAR; PG8_SCHED;
            PG8_STAGE(PG8_SB(1, 1), b3 + hstep, voffB);
            PG8_WAIT_V(6); PG8_BAR; PG8_MMA(1, 1, At, B1); PG8_BAR;
            }
        }
        if constexpr (ALIGN_EPI) { if (wr == 0) PG8_BAR; }
        if constexpr (!Epi::AFTER_DRAIN) { int fr_e = fr, fq_e = fq; asm volatile("" : "+v"(fr_e), "+v"(fq_e));
            E(acc, cur, wr, wc, fr_e, fq_e); S.done(cur); }
        if (!has_next) break;
#pragma unroll
        for (int a = 0; a < 2; ++a)
#pragma unroll
            for (int b = 0; b < 2; ++b)
#pragma unroll
                for (int m = 0; m < 4; ++m)
#pragma unroll
                    for (int n = 0; n < 2; ++n) acc[a][b][m][n] = pg8_zero4();
        cur = nxt; cA = nA; cB = nB; ++ui;
        if constexpr (GATHER) PG8_ROWS(ui, gC);
        if constexpr (ALIGN_EPI) { if (wr == 1) PG8_BAR; }
    }
    PG8_WAIT_V(0);
    if constexpr (!ALIGN_EPI) { if (wr == 0) PG8_BAR; }
    PG8_BAR;
    if constexpr (Epi::AFTER_DRAIN) { E.fused(acc, cur, wr, wc, fr, fq, lds, wid, lane); S.done(cur); }
#undef PG8_SA
#undef PG8_SB
#undef PG8_STAGE
#undef PG8_LDA
#undef PG8_STAGE_A
#undef PG8_ROWS
#undef PG8_LDB
#undef PG8_MMA
#undef PG8_WAIT_V
#undef PG8_WAIT_L
#undef PG8_BAR
#undef PG8_SCHED
}
}
#define XB_TMO      128
#define XB_XCNT(j)  (256  + 64 * (j))
#define XB_XSUB(j)  (1280 + 64 * (j))
#define XB_XGEN(j)  (2304 + 64 * (j))
#define XB_TOP      3328
#define XB_TOPGEN   3392
#define XCD_BAR_WORDS 3456
#define XB_SPIN_CAP (1u << 18)

__device__ __forceinline__ unsigned xb_ld(unsigned* p)              { return __hip_atomic_load(p, __ATOMIC_RELAXED, __HIP_MEMORY_SCOPE_AGENT); }
__device__ __forceinline__ unsigned xb_add(unsigned* p, unsigned v) { return __hip_atomic_fetch_add(p, v, __ATOMIC_RELAXED, __HIP_MEMORY_SCOPE_AGENT); }
__device__ __forceinline__ unsigned xb_xcc_id() { return (unsigned)__builtin_amdgcn_s_getreg((3 << 11) | 20) & 0xFu; }
#define XB_SPIN(cond, bar) do { unsigned _sp = 0; while (cond) { __builtin_amdgcn_s_sleep(1); \
    if ((++_sp & 255u) == 0u) { if (xb_ld(&(bar)[XB_TMO])) break; if (_sp > XB_SPIN_CAP) { atomicAdd(&(bar)[XB_TMO], 1u); break; } } } } while (0)

struct XcdBarrier {
    unsigned* bar; unsigned x; int wid;
    volatile LAS unsigned* st;
};

__device__ __forceinline__ bool xb_leader(int wid) { int l; asm volatile("v_mbcnt_lo_u32_b32 %0, -1, 0\n\tv_mbcnt_hi_u32_b32 %0, -1, %0" : "=v"(l)); return wid == 0 && l == 0; }
__device__ __forceinline__ XcdBarrier xcd_barrier_post(unsigned* bar, volatile LAS unsigned* st, int wid) {
    XcdBarrier b; b.bar = bar; b.x = xb_xcc_id(); b.st = st; b.wid = wid;
    if (xb_leader(wid)) (void)xb_add(&bar[XB_XCNT(b.x)], 1u);
    return b;
}
__device__ __forceinline__ void xcd_barrier_complete(unsigned* bar, unsigned x, unsigned& nloc, unsigned& nx) {
    const unsigned G = gridDim.x * gridDim.y * gridDim.z;
    unsigned sum, cnt, mine, sp = 0u;
    for (;;) {
        sum = 0u; cnt = 0u; mine = 0u;
#pragma unroll
        for (unsigned j = 0; j < 16; ++j) { const unsigned c = xb_ld(&bar[XB_XCNT(j)]); sum += c; cnt += (c > 0u) ? 1u : 0u; mine = (j == x) ? c : mine; }
        if (sum == G) break;
        __builtin_amdgcn_s_sleep(1);
        if ((++sp & 255u) == 0u) { if (xb_ld(&bar[XB_TMO])) break; if (sp > XB_SPIN_CAP) { atomicAdd(&bar[XB_TMO], 1u); break; } }
    }
    nloc = mine > 0u ? mine : 1u; nx = cnt > 0u ? cnt : 1u;
}

__device__ __forceinline__ void xcd_barrier(const XcdBarrier& b) {
    asm volatile("s_waitcnt vmcnt(0)" ::: "memory");
    __syncthreads();
    if (xb_leader(b.wid)) {
        unsigned* bar = b.bar; asm volatile("" : "+s"(bar));
        __builtin_amdgcn_s_waitcnt(0);
        unsigned nloc = b.st[0], nx = b.st[1];
        if (nloc == 0u) { xcd_barrier_complete(bar, b.x, nloc, nx); b.st[0] = nloc; b.st[1] = nx; }
        const unsigned old = xb_add(&bar[XB_XSUB(b.x)], 1u);
        const unsigned gen = old / nloc;
        if (old + 1u == (gen + 1u) * nloc) {
            __builtin_amdgcn_fence(__ATOMIC_RELEASE, "agent");
            asm volatile("s_waitcnt vmcnt(0)" ::: "memory");
            const unsigned og = xb_add(&bar[XB_TOP], 1u);
            const unsigned tg = og / nx;
            if (og + 1u == (tg + 1u) * nx) xb_add(&bar[XB_TOPGEN], 1u);
            else XB_SPIN(xb_ld(&bar[XB_TOPGEN]) == tg, bar);
            __builtin_amdgcn_fence(__ATOMIC_ACQUIRE, "agent");
            xb_add(&bar[XB_XGEN(b.x)], 1u);
            asm volatile("s_waitcnt vmcnt(0)" ::: "memory");
        } else {
            XB_SPIN(xb_ld(&bar[XB_XGEN(b.x)]) == gen, bar);
            __builtin_amdgcn_fence(__ATOMIC_ACQUIRE, "agent");
            asm volatile("s_waitcnt vmcnt(0)" ::: "memory");
        }
    }
    __syncthreads();
}

constexpr int NB = 4, SEQ = 8192, DM = 1024, NTOK = NB * SEQ, DEPTH = 2;
constexpr int W_IN_COLS = 7076;
constexpr int C_QA = 0, C_KA = 256, C_VA = 512, C_IQ = 768, C_IK = 896, C_IW = 928, C_UB = 932, C_VB = 1188, C_QC = 1444, C_KC = 1700, C_VC = 1956,
              C_BD = 2212, C_CD = 2468, C_XD = 2724, C_GATE = 2980;
constexpr int NEXP = 32, DEXP = 256, TOPK_SEL = 256;
constexpr float EPS = 1e-6f;
constexpr int NWAVES = 8, NTHR = 512;

constexpr size_t MiB = 1u << 20;
constexpr size_t WS_CTL = 0, CTL_ZERO_BYTES = 1 * MiB;
constexpr size_t WS_WP = 1 * MiB;
constexpr size_t WS_WV = 6 * MiB;
constexpr size_t WS_WG = 7 * MiB;
constexpr size_t WS_WB = 15 * MiB;
constexpr size_t WS_WO = 17 * MiB;
constexpr size_t WS_WGU = 19 * MiB;
constexpr size_t WS_WD = 51 * MiB;
constexpr size_t WS_WS = 67 * MiB;
constexpr size_t WS_ROPE = 68 * MiB;
constexpr size_t WS_MISC = 80 * MiB;
constexpr size_t WS_H = 84 * MiB;
constexpr size_t WS_Y = 148 * MiB;
constexpr size_t WS_BIG = 212 * MiB;
constexpr size_t WS_END = 468 * MiB;
constexpr size_t PO_QA = WS_BIG + 0 * MiB, PO_KA = WS_BIG + 16 * MiB, PO_UB = WS_BIG + 32 * MiB, PO_VB = WS_BIG + 48 * MiB, PO_QC = WS_BIG + 64 * MiB, PO_KC = WS_BIG + 80 * MiB,
                 PO_BD = WS_BIG + 96 * MiB, PO_CD = WS_BIG + 112 * MiB, PO_XD = WS_BIG + 128 * MiB,
                 PO_VT = WS_BIG + 144 * MiB,
                 PO_IQ = WS_BIG + 176 * MiB,
                 PO_IK = WS_BIG + 184 * MiB,
                 PO_SELM = WS_BIG + 192 * MiB;
constexpr int MOE_MAXROWS = 65536 + 32 * 256;
constexpr size_t MO_H2 = WS_BIG;
constexpr size_t WS_DELTA = WS_BIG + 192 * MiB;
constexpr size_t MO_Y0 = WS_BIG + 64 * MiB, MO_Y1 = WS_BIG + 96 * MiB;
constexpr float Y_SCALE = 64.0f;
constexpr size_t MO_HH = WS_BIG + 144 * MiB;
constexpr size_t MI_THR = WS_MISC;
constexpr size_t MI_IW = WS_MISC + 256 * 1024;
constexpr size_t MI_RSTD = WS_MISC + 768 * 1024;
constexpr size_t MI_EID = WS_MISC + 896 * 1024;
constexpr size_t MI_EW = WS_MISC + 1152 * 1024;
constexpr size_t MI_CNT = WS_MISC + 1408 * 1024;
constexpr size_t MI_RTOK = WS_MISC + 1536 * 1024;
constexpr size_t MI_RW = WS_MISC + 1536 * 1024 + 512 * 1024;
static_assert(MI_RW + MOE_MAXROWS * 4 <= WS_H, "misc region");
constexpr int CW_BAR = 4096;
constexpr int CW_TMO = 12288;
constexpr int CW_TCNT = 16384;
constexpr int TCNT_LAYER = 288 * 64;
static_assert((CW_TCNT + DEPTH * TCNT_LAYER) * 4 <= (int)CTL_ZERO_BYTES, "tile counters inside the zeroed control region");

constexpr int RING_BYTES = 131072;
constexpr int LDS_BYTES = 163840;
constexpr int MISC_OFF = LDS_BYTES - 256;
constexpr int TAB_OFF = RING_BYTES;

typedef unsigned short bf16;
typedef unsigned v4u __attribute__((ext_vector_type(4)));
typedef unsigned v2u __attribute__((ext_vector_type(2)));
typedef float f32x4 __attribute__((ext_vector_type(4)));
typedef float f32x2 __attribute__((ext_vector_type(2)));
typedef short bf16x8 __attribute__((ext_vector_type(8)));
#define LDS_WAIT() asm volatile("s_waitcnt lgkmcnt(0)" ::: "memory")
#define VM_WAIT() asm volatile("s_waitcnt vmcnt(0)" ::: "memory")
__device__ __forceinline__ unsigned pk2(float lo, float hi) { return pg8::cvt_pk_bf16(lo, hi); }
__device__ __forceinline__ float bf_lo(unsigned u) { return __builtin_bit_cast(float, u << 16); }
__device__ __forceinline__ float bf_hi(unsigned u) { return __builtin_bit_cast(float, u & 0xffff0000u); }
__device__ __forceinline__ float bf1(bf16 u) { return __builtin_bit_cast(float, (unsigned)u << 16); }
__device__ __forceinline__ float fexp2(float x) { return __builtin_amdgcn_exp2f(x); }
__device__ __forceinline__ float flog2(float x) { return __builtin_amdgcn_logf(x); }
__device__ __forceinline__ float frcp(float x) { return __builtin_amdgcn_rcpf(x); }
__device__ __forceinline__ int lane_id_opaque() { int l; asm volatile("v_mbcnt_lo_u32_b32 %0, -1, 0\n\tv_mbcnt_hi_u32_b32 %0, -1, %0" : "=v"(l)); return l; }
__device__ __forceinline__ float shx(float v, int mask, int lane) { return __builtin_bit_cast(float, __builtin_amdgcn_ds_bpermute((lane ^ mask) << 2, __builtin_bit_cast(int, v))); }
__device__ __forceinline__ float shdown(float v, int d, int lane) { return __builtin_bit_cast(float, __builtin_amdgcn_ds_bpermute(((lane + d) & 63) << 2, __builtin_bit_cast(int, v))); }
__device__ __forceinline__ unsigned shdown_u(unsigned v, int d, int lane) { return (unsigned)__builtin_amdgcn_ds_bpermute(((lane + d) & 63) << 2, (int)v); }
__device__ __forceinline__ unsigned shup_u(unsigned v, int d, int lane) { return (unsigned)__builtin_amdgcn_ds_bpermute(((lane - d) & 63) << 2, (int)v); }
__device__ __forceinline__ unsigned wave_prefix_incl_u(unsigned v) {
    v += (unsigned)__builtin_amdgcn_update_dpp(0, (int)v, 0x111, 0xf, 0xf, false);
    v += (unsigned)__builtin_amdgcn_update_dpp(0, (int)v, 0x112, 0xf, 0xf, false);
    v += (unsigned)__builtin_amdgcn_update_dpp(0, (int)v, 0x114, 0xf, 0xf, false);
    v += (unsigned)__builtin_amdgcn_update_dpp(0, (int)v, 0x118, 0xf, 0xf, false);
    v += (unsigned)__builtin_amdgcn_update_dpp(0, (int)v, 0x142, 0xa, 0xf, false);
    v += (unsigned)__builtin_amdgcn_update_dpp(0, (int)v, 0x143, 0xc, 0xf, false);
    return v;
}
__device__ __forceinline__ float wave_sum(float v, int lane) {
    (void)lane;
    v += __builtin_bit_cast(float, __builtin_amdgcn_update_dpp(0, __builtin_bit_cast(int, v), 0x111, 0xf, 0xf, false));
    v += __builtin_bit_cast(float, __builtin_amdgcn_update_dpp(0, __builtin_bit_cast(int, v), 0x112, 0xf, 0xf, false));
    v += __builtin_bit_cast(float, __builtin_amdgcn_update_dpp(0, __builtin_bit_cast(int, v), 0x114, 0xf, 0xf, false));
    v += __builtin_bit_cast(float, __builtin_amdgcn_update_dpp(0, __builtin_bit_cast(int, v), 0x118, 0xf, 0xf, false));
    v += __builtin_bit_cast(float, __builtin_amdgcn_update_dpp(0, __builtin_bit_cast(int, v), 0x142, 0xa, 0xf, false));
    v += __builtin_bit_cast(float, __builtin_amdgcn_update_dpp(0, __builtin_bit_cast(int, v), 0x143, 0xc, 0xf, false));
    return __builtin_bit_cast(float, __builtin_amdgcn_readlane(__builtin_bit_cast(int, v), 63));
}

__device__ __forceinline__ f32x4 idx_score(const bf16x8 A, const bf16x8 (&Bq)[4], const float (&clo)[4], const float (&chi)[4]) {
    const f32x4 z = {0.f, 0.f, 0.f, 0.f};
    const f32x4 d0 = __builtin_amdgcn_mfma_f32_16x16x32_bf16(A, Bq[0], z, 0, 0, 0), d1 = __builtin_amdgcn_mfma_f32_16x16x32_bf16(A, Bq[1], z, 0, 0, 0),
                d2 = __builtin_amdgcn_mfma_f32_16x16x32_bf16(A, Bq[2], z, 0, 0, 0), d3 = __builtin_amdgcn_mfma_f32_16x16x32_bf16(A, Bq[3], z, 0, 0, 0);
    f32x4 m0, m1, m2, m3;
#pragma unroll
    for (int r = 0; r < 4; ++r) { m0[r] = __builtin_amdgcn_fmed3f(d0[r], clo[0], chi[0]); m1[r] = __builtin_amdgcn_fmed3f(d1[r], clo[1], chi[1]); m2[r] = __builtin_amdgcn_fmed3f(d2[r], clo[2], chi[2]); m3[r] = __builtin_amdgcn_fmed3f(d3[r], clo[3], chi[3]); }
    return (((z + m0) + m1) + m2) + m3;
}
constexpr float IDX_SCALE = 8.0f;

#define CAS4 __attribute__((address_space(4)))
typedef const void* inptr_t;
struct Frame {
    LAS unsigned char* lds;
    volatile LAS unsigned* MISC;
    int tid, lane, wave, G, bid;
    unsigned char* ws;
    float* out;
    const CAS4 inptr_t* kin;
    __device__ __forceinline__ const float* x_in() const { return (const float*)kin[0]; }
    __device__ __forceinline__ const int* positions() const { return (const int*)kin[1]; }
    __device__ __forceinline__ const float* norm1_g() const { return (const float*)kin[2]; }
    __device__ __forceinline__ const float* w_in() const { return (const float*)kin[3]; }
    __device__ __forceinline__ const float* sgu_ln_g() const { return (const float*)kin[4]; }
    __device__ __forceinline__ const float* sgu_ln_b() const { return (const float*)kin[5]; }
    __device__ __forceinline__ const float* w_spatial() const { return (const float*)kin[6]; }
    __device__ __forceinline__ const float* b_spatial() const { return (const float*)kin[7]; }
    __device__ __forceinline__ const float* conv_w() const { return (const float*)kin[8]; }
    __device__ __forceinline__ const float* w_branch() const { return (const float*)kin[9]; }
    __device__ __forceinline__ const float* w_out() const { return (const float*)kin[10]; }
    __device__ __forceinline__ const float* norm2_g() const { return (const float*)kin[11]; }
    __device__ __forceinline__ const float* w_rg() const { return (const float*)kin[12]; }
    __device__ __forceinline__ const float* b_rg() const { return (const float*)kin[13]; }
    __device__ __forceinline__ const float* w_re() const { return (const float*)kin[14]; }
    __device__ __forceinline__ const float* b_re() const { return (const float*)kin[15]; }
    __device__ __forceinline__ const float* w_eg() const { return (const float*)kin[16]; }
    __device__ __forceinline__ const float* w_eu() const { return (const float*)kin[17]; }
    __device__ __forceinline__ const float* w_ed() const { return (const float*)kin[18]; }
    __device__ __forceinline__ const float* norm_f_g() const { return (const float*)kin[19]; }
};
template <class T> __device__ __forceinline__ T* wsp(const Frame& F, size_t off) { return (T*)(F.ws + off); }
template <class T> __device__ __forceinline__ T* launder_s(T* p) { asm volatile("" : "+s"(p)); return p; }
__device__ __forceinline__ Frame phase_frame(const Frame& F0) { Frame F = F0; int l = lane_id_opaque(); int w = F0.wave; asm volatile("" : "+s"(w));
    F.lane = l; F.wave = w; F.tid = w * 64 + l; F.ws = launder_s(F0.ws); F.kin = launder_s(F0.kin); return F; }

__device__ __forceinline__ int proj_col(int nr) {
    const int t = nr >> 8, c = nr & 255;
    if (t <= 1) { const int hh = c >> 6, w = c & 63, g = w >> 3, n = (w >> 2) & 1, e = w & 3; return (t == 0 ? C_QA : C_KA) + hh * 64 + n * 32 + 4 * g + e; }
    if (t == 2) {
        if (c < 160) { const int w = c & 31, fq = w >> 3, n = (w >> 2) & 1, e = w & 3, o = n * 16 + 4 * fq + e; return c < 128 ? C_IQ + (c >> 5) * 32 + o : C_IK + o; }
        if (c < 164) return C_IW + (c - 160);
        return -1;
    }
    switch (t) { case 3: return C_UB + c; case 4: return C_VB + c; case 5: return C_QC + c; case 6: return C_KC + c; case 7: return C_BD + c; case 8: return C_CD + c; default: return C_XD + c; }
}
__device__ __forceinline__ int gate_col(int nr) {
    const int pn = nr >> 8, c = nr & 255, bj = c >> 7, wc = (c >> 5) & 3, n = (c >> 4) & 1, fq = (c >> 2) & 3, e = c & 3;
    return C_GATE + (2 * bj + n) * 1024 + 64 * pn + 16 * wc + 4 * fq + e;
}
struct TrItem { const float* p4; int ld; bf16* dst; int K, n0, k0; float scale; };
constexpr int IT_WP = 16 * 80, IT_WV = 16 * 16, IT_WG = 16 * 128, IT_WB = 4 * 128, IT_WO = 16 * 32, IT_WGU = 16 * 512, IT_WD = 4 * 1024;
constexpr int IT_TOTAL = IT_WP + IT_WV + IT_WG + IT_WB + IT_WO + IT_WGU + IT_WD;
__device__ __forceinline__ TrItem tr_decode(const Frame& F, int layer, int it, int lane) {
    TrItem t; int r = it; const int c4 = (lane & 7) * 4; t.scale = 1.0f;
    const float* w_in = F.w_in() + (size_t)layer * DM * W_IN_COLS;
    if (r < IT_WP) { const int nb = r % 80, kb = r / 80, c = proj_col(nb * 32 + c4); t.p4 = c < 0 ? nullptr : w_in + c; t.ld = W_IN_COLS; t.dst = wsp<bf16>(F, WS_WP); t.K = 1024; t.n0 = nb * 32; t.k0 = kb * 64; }
    else if ((r -= IT_WP) < IT_WV) { const int nb = r % 16, kb = r / 16, nr = nb * 32 + c4; t.p4 = w_in + (nr < 256 ? C_VA + nr : C_VC + nr - 256); t.ld = W_IN_COLS; t.dst = wsp<bf16>(F, WS_WV); t.K = 1024; t.n0 = nb * 32; t.k0 = kb * 64; }
    else if ((r -= IT_WV) < IT_WG) { const int nb = r % 128, kb = r / 128; t.scale = -1.4426950408889634f;
        t.p4 = w_in + gate_col(nb * 32 + c4); t.ld = W_IN_COLS; t.dst = wsp<bf16>(F, WS_WG); t.K = 1024; t.n0 = nb * 32; t.k0 = kb * 64; }
    else if ((r -= IT_WG) < IT_WB) { const int nb = r % 128, kb = r / 128, nr = nb * 32 + c4; t.p4 = F.w_branch() + (size_t)layer * 4 * 256 * 1024 + (size_t)(nr >> 10) * 256 * 1024 + (nr & 1023); t.ld = 1024; t.scale = 8.0f; t.dst = wsp<bf16>(F, WS_WB); t.K = 256; t.n0 = nb * 32; t.k0 = kb * 64; }
    else if ((r -= IT_WB) < IT_WO) { const int nb = r % 32, kb = r / 32; t.p4 = F.w_out() + (size_t)layer * 1024 * 1024 + nb * 32 + c4; t.ld = 1024; t.scale = 0.125f; t.dst = wsp<bf16>(F, WS_WO); t.K = 1024; t.n0 = nb * 32; t.k0 = kb * 64; }
    else if ((r -= IT_WO) < IT_WGU) { const int nb = r % 512, kb = r / 512, nr = nb * 32 + c4, e = nr >> 9, rr = nr & 511, jj = rr >> 8, bj = (rr >> 7) & 1, f = 128 * jj + (rr & 127);
        t.p4 = (bj ? F.w_eu() : F.w_eg()) + (size_t)layer * NEXP * 1024 * 256 + (size_t)e * 1024 * 256 + f; t.ld = 256; t.dst = wsp<bf16>(F, WS_WGU); t.K = 1024; t.n0 = nb * 32; t.k0 = kb * 64; }
    else { r -= IT_WGU; const int nb = r % 1024, kb = r / 1024, nr = nb * 32 + c4; t.p4 = F.w_ed() + (size_t)layer * NEXP * 256 * 1024 + (size_t)(nr >> 10) * 256 * 1024 + (nr & 1023); t.ld = 1024; t.dst = wsp<bf16>(F, WS_WD); t.K = 256; t.n0 = nb * 32; t.k0 = kb * 64; }
    return t;
}
__device__ __forceinline__ void tr_load(const TrItem& t, int lane, f32x4 (&tv)[8]) {
#pragma unroll
    for (int i = 0; i < 8; ++i) { const int kk = 8 * i + (lane >> 3); tv[i] = t.p4 ? *(const f32x4*)(t.p4 + (size_t)(t.k0 + kk) * t.ld) : (f32x4){0.f, 0.f, 0.f, 0.f}; }
}
__device__ __forceinline__ void tr_store(const TrItem& t, int lane, const f32x4 (&tv)[8], LAS float* scr) {
#pragma unroll
    for (int i = 0; i < 8; ++i) { const int kk = 8 * i + (lane >> 3); *(LAS f32x4*)(scr + kk * 36 + (lane & 7) * 4) = tv[i]; }
    LDS_WAIT(); asm volatile("" ::: "memory");
    const int c = lane & 7;
#pragma unroll
    for (int j = 0; j < 4; ++j) { const int n = (lane >> 3) + 8 * j; const LAS float* s = scr + (8 * c) * 36 + n;
        const float sc = t.scale; v4u o; o.x = pk2(s[0 * 36] * sc, s[1 * 36] * sc); o.y = pk2(s[2 * 36] * sc, s[3 * 36] * sc); o.z = pk2(s[4 * 36] * sc, s[5 * 36] * sc); o.w = pk2(s[6 * 36] * sc, s[7 * 36] * sc);
        *(GAS v4u*)(t.dst + (size_t)(t.n0 + n) * t.K + t.k0 + 8 * c) = o; }
    LDS_WAIT(); asm volatile("" ::: "memory");
}
__device__ __forceinline__ void l0_weights(const Frame& F0, int layer) {
    const Frame F = phase_frame(F0);
    LAS float* scr = (LAS float*)(F.lds + F.wave * 16384);
    const int gw = F.bid * NWAVES + F.wave, NGW = F.G * NWAVES, lane = F.lane;
    if (gw < IT_TOTAL) {
        TrItem cur = tr_decode(F, layer, gw, lane); f32x4 tv[8]; tr_load(cur, lane, tv);
        for (int it = gw; it < IT_TOTAL; it += NGW) {
            const int itn = it + NGW; const bool more = itn < IT_TOTAL;
            TrItem nxt = cur; f32x4 tn[8];
            if (more) { nxt = tr_decode(F, layer, itn, lane); tr_load(nxt, lane, tn); }
            tr_store(cur, lane, tv, scr);
            if (more) { cur = nxt;
#pragma unroll
                for (int i = 0; i < 8; ++i) tv[i] = tn[i]; }
        }
    }
    const float* wsrc = F.w_spatial() + (size_t)layer * 4 * 128 * 128; bf16* wdst = wsp<bf16>(F, WS_WS);
    for (int i = F.bid * NTHR + F.tid; i < 4 * 128 * 128; i += F.G * NTHR) { const int s = i & 127, t = (i >> 7) & 127; const float v = s <= t ? wsrc[i] : 0.f; wdst[i] = (bf16)(pk2(v, 0.f) & 0xffffu); }
}
__device__ __forceinline__ void l0_rope(const Frame& F0) {
    const Frame F = phase_frame(F0);
    float* cosA = wsp<float>(F, WS_ROPE); float* sinA = cosA + (size_t)NTOK * 32; float* cosI = sinA + (size_t)NTOK * 32; float* sinI = cosI + (size_t)NTOK * 16;
    for (int i = F.bid * NTHR + F.tid; i < NTOK * 48; i += F.G * NTHR) {
        const int tok = i / 48, j = i % 48; const bool isA = j < 32; const int fi = isA ? j : j - 32;
        const float ex = isA ? (float)fi * (1.0f / 32.0f) : (float)fi * (1.0f / 16.0f);
        const float inv = exp2f(-ex * 13.287712379549449f);
        const float ang = (float)F.positions()[tok] * inv;
        double t = (double)ang * 0.15915494309189535; t -= floor(t);
        const float rev = (float)t; const float sn = __builtin_amdgcn_sinf(rev), cs = __builtin_amdgcn_cosf(rev);
        if (isA) { cosA[(size_t)tok * 32 + fi] = cs; sinA[(size_t)tok * 32 + fi] = sn; } else { cosI[(size_t)tok * 16 + fi] = cs; sinI[(size_t)tok * 16 + fi] = sn; }
    }
}
template <int MODE, bool FINAL> __device__ __forceinline__ void rms_rows(const Frame& F0, int layer) {
    const Frame F = phase_frame(F0);
    const int prev = FINAL ? DEPTH - 1 : layer - 1;
    const float* xin = (MODE == 0 || prev == 0) ? F.x_in() : F.out; float* xout = F.out; const bf16* dl = wsp<bf16>(F, WS_DELTA); const unsigned char* y0 = wsp<unsigned char>(F, MO_Y0); const unsigned char* y1 = wsp<unsigned char>(F, MO_Y1); bf16* h = wsp<bf16>(F, WS_H);
    const float* g = FINAL ? F.norm_f_g() : F.norm1_g() + layer * DM;
    const int gw = F.bid * NWAVES + F.wave, NGW = F.G * NWAVES, lane = F.lane;
    f32x4 gv[4];
#pragma unroll
    for (int j = 0; j < 4; ++j) gv[j] = *(const f32x4*)(g + 4 * lane + 256 * j);
    constexpr int RB = MODE == 0 ? 4 : 2;
    for (int m0 = gw; m0 < NTOK; m0 += NGW * RB) {
        f32x4 v[RB][4]; unsigned ya[RB][4], yb[RB][4]; v2u yd[RB][4]; float s[RB];
#pragma unroll
        for (int rb = 0; rb < RB; ++rb) { const int m = m0 + rb * NGW; const GAS f32x4* xr = (const GAS f32x4*)(xin + (size_t)m * DM) + lane;
#pragma unroll
            for (int j = 0; j < 4; ++j) { v[rb][j] = xr[64 * j];
                if (MODE == 1) { ya[rb][j] = *(const GAS unsigned*)(y0 + (size_t)m * DM + 4 * lane + 256 * j); yb[rb][j] = *(const GAS unsigned*)(y1 + (size_t)m * DM + 4 * lane + 256 * j); yd[rb][j] = *(const GAS v2u*)(dl + (size_t)m * DM + 4 * lane + 256 * j); } } }
#pragma unroll
        for (int rb = 0; rb < RB; ++rb) { s[rb] = 0.f;
#pragma unroll
            for (int j = 0; j < 4; ++j) {
                if (MODE == 1) { const v2u d = yd[rb][j]; const int a = (int)ya[rb][j], b = (int)yb[rb][j]; constexpr float YI = 1.0f / Y_SCALE;
                    const f32x2 alo = __builtin_amdgcn_cvt_pk_f32_fp8(a, false), ahi = __builtin_amdgcn_cvt_pk_f32_fp8(a, true), blo = __builtin_amdgcn_cvt_pk_f32_fp8(b, false), bhi = __builtin_amdgcn_cvt_pk_f32_fp8(b, true);
                    v[rb][j].x = (v[rb][j].x + bf_lo(d.x)) + (alo.x + blo.x) * YI; v[rb][j].y = (v[rb][j].y + bf_hi(d.x)) + (alo.y + blo.y) * YI;
                    v[rb][j].z = (v[rb][j].z + bf_lo(d.y)) + (ahi.x + bhi.x) * YI; v[rb][j].w = (v[rb][j].w + bf_hi(d.y)) + (ahi.y + bhi.y) * YI; }
                s[rb] += (v[rb][j].x * v[rb][j].x + v[rb][j].y * v[rb][j].y) + (v[rb][j].z * v[rb][j].z + v[rb][j].w * v[rb][j].w); } }
#pragma unroll
        for (int rb = 0; rb < RB; ++rb) { const int m = m0 + rb * NGW;
            const float rstd = 1.0f / sqrtf(wave_sum(s[rb], lane) * (1.0f / DM) + EPS);
            if (FINAL) { GAS f32x4* o = (GAS f32x4*)(xout + (size_t)m * DM) + lane;
#pragma unroll
                for (int j = 0; j < 4; ++j) o[64 * j] = v[rb][j] * rstd * gv[j];
            } else {
                if (MODE == 1) { GAS f32x4* o = (GAS f32x4*)(xout + (size_t)m * DM) + lane;
#pragma unroll
                    for (int j = 0; j < 4; ++j) o[64 * j] = v[rb][j]; }
                GAS v2u* o8 = (GAS v2u*)(h + (size_t)m * DM) + lane;
#pragma unroll
                for (int j = 0; j < 4; ++j) { const f32x4 t = v[rb][j] * rstd * gv[j]; v2u w; w.x = pk2(t.x, t.y); w.y = pk2(t.z, t.w); o8[64 * j] = w; }
            }
        }
    }
}

typedef pg8::Unit Unit;

constexpr float LOG2E = 1.4426950408889634f;
__device__ __forceinline__ float sigmoidf_(float g) { return frcp(1.0f + fexp2(-g * LOG2E)); }
__device__ __forceinline__ float gelu_tanh(float x) { const float e = fexp2(x * (-2.302208198f + -0.102943240f * x * x)); return x * frcp(1.0f + e); }
__device__ __forceinline__ v4u pack8(const f32x4& a, const f32x4& b) { v4u w; w.x = pk2(a.x, a.y); w.y = pk2(a.z, a.w); w.z = pk2(b.x, b.y); w.w = pk2(b.z, b.w); return w; }

struct EpiStoreBf16 {
    static constexpr bool PERM = true, AFTER_DRAIN = false;
    bf16* O; int ldc; int pn_mask;
    __device__ __forceinline__ void operator()(const f32x4 (&acc)[2][2][4][2], const Unit& u, int wr, int wc, int fr, int fq) const {
        bf16* const O = launder_s(this->O);
        const int row0 = u.pm * 256 + wr * 64 + fr, col0 = (u.pn & pn_mask) * 256 + wc * 32 + 8 * fq;
#pragma unroll
        for (int ai = 0; ai < 2; ++ai)
#pragma unroll
            for (int m = 0; m < 4; ++m) { bf16* rowp = O + (size_t)(row0 + ai * 128 + m * 16) * ldc + col0;
#pragma unroll
                for (int bj = 0; bj < 2; ++bj) *(GAS v4u*)(rowp + bj * 128) = pack8(acc[ai][bj][m][0], acc[ai][bj][m][1]); }
    }
};
struct EpiProj {
    static constexpr bool PERM = true, AFTER_DRAIN = false;
    unsigned char* ws;
    __device__ __forceinline__ void operator()(const f32x4 (&acc)[2][2][4][2], const Unit& u, int wr, int wc, int fr, int fq) const {
        unsigned char* const ws = launder_s(this->ws);
        const int t = u.pn, row0 = u.pm * 256 + wr * 64 + fr, col0 = wc * 32 + 8 * fq;
        const float* cosA = (const float*)(ws + WS_ROPE); const float* sinA = cosA + (size_t)NTOK * 32; const float* cosI = sinA + (size_t)NTOK * 32; const float* sinI = cosI + (size_t)NTOK * 16;
        if (t <= 1) {
            bf16* O = (bf16*)(ws + (t == 0 ? PO_QA : PO_KA)); const float sc = t == 0 ? 0.125f * LOG2E : 1.0f; const int g4 = ((wc & 1) * 4 + fq) * 4;
#pragma unroll
            for (int ai = 0; ai < 2; ++ai) {
                f32x4 cc[4], ss[4];
#pragma unroll
                for (int m = 0; m < 4; ++m) { const int row = row0 + ai * 128 + m * 16; cc[m] = *(const GAS f32x4*)(cosA + (size_t)row * 32 + g4); ss[m] = *(const GAS f32x4*)(sinA + (size_t)row * 32 + g4); }
#pragma unroll
                for (int m = 0; m < 4; ++m) { const int row = row0 + ai * 128 + m * 16; const f32x4 c4 = cc[m] * sc, s4 = ss[m] * sc;
#pragma unroll
                    for (int bj = 0; bj < 2; ++bj) { const f32x4 x1 = acc[ai][bj][m][0], x2 = acc[ai][bj][m][1];
                        *(GAS v4u*)(O + (size_t)row * 256 + bj * 128 + col0) = pack8(x1 * c4 - x2 * s4, x2 * c4 + x1 * s4); } } }
        } else if (t == 2) {
            bf16* IQ = (bf16*)(ws + PO_IQ); bf16* IK = (bf16*)(ws + PO_IK); float* IW = (float*)(ws + MI_IW);
#pragma unroll
            for (int ai = 0; ai < 2; ++ai) {
                f32x4 cI[4], sI[4];
#pragma unroll
                for (int m = 0; m < 4; ++m) { const int row = row0 + ai * 128 + m * 16; cI[m] = *(const GAS f32x4*)(cosI + (size_t)row * 16 + 4 * fq); sI[m] = *(const GAS f32x4*)(sinI + (size_t)row * 16 + 4 * fq); }
                __builtin_amdgcn_sched_barrier(0);
#pragma unroll
                for (int m = 0; m < 4; ++m) { const int row = row0 + ai * 128 + m * 16;
                    const f32x4 c4 = cI[m], s4 = sI[m];
                    { const f32x4 x1 = acc[ai][0][m][0], x2 = acc[ai][0][m][1]; *(GAS v4u*)(IQ + (size_t)row * 128 + col0) = pack8(x1 * c4 - x2 * s4, x2 * c4 + x1 * s4); }
                    if (wc == 0) { const f32x4 x1 = acc[ai][1][m][0], x2 = acc[ai][1][m][1]; *(GAS v4u*)(IK + (size_t)row * 32 + 8 * fq) = pack8(x1 * c4 - x2 * s4, x2 * c4 + x1 * s4); }
                    if (wc == 1 && fq == 0) *(GAS f32x4*)(IW + (size_t)row * 4) = acc[ai][1][m][0]; } }
        } else {
            size_t off; switch (t) { case 3: off = PO_UB; break; case 4: off = PO_VB; break; case 5: off = PO_QC; break; case 6: off = PO_KC; break; case 7: off = PO_BD; break; case 8: off = PO_CD; break; default: off = PO_XD; break; }
            bf16* O = (bf16*)(ws + off); const bool act = (t == 3 || t == 4); const float sc = t == 5 ? 0.125f : 1.0f;
#pragma unroll
            for (int ai = 0; ai < 2; ++ai)
#pragma unroll
                for (int m = 0; m < 4; ++m) { bf16* rowp = O + (size_t)(row0 + ai * 128 + m * 16) * 256 + col0;
#pragma unroll
                    for (int bj = 0; bj < 2; ++bj) { f32x4 a = acc[ai][bj][m][0] * sc, b = acc[ai][bj][m][1] * sc;
                        if (act) {
#pragma unroll
                            for (int e = 0; e < 4; ++e) { a[e] = gelu_tanh(a[e]); b[e] = gelu_tanh(b[e]); } }
                        *(GAS v4u*)(rowp + bj * 128) = pack8(a, b); } }
        }
    }
};
__device__ __forceinline__ size_t p_index(int br, int row, int c) { return ((size_t)(br * 64 + (c >> 4)) * NTOK + row) * 16 + (c & 15); }
__device__ __forceinline__ unsigned fp8x4(const f32x4& v) {
    const float a = __builtin_amdgcn_fmed3f(v.x, -448.0f, 448.0f), b = __builtin_amdgcn_fmed3f(v.y, -448.0f, 448.0f), c = __builtin_amdgcn_fmed3f(v.z, -448.0f, 448.0f), d = __builtin_amdgcn_fmed3f(v.w, -448.0f, 448.0f);
    int w = __builtin_amdgcn_cvt_pk_fp8_f32(a, b, 0, false); w = __builtin_amdgcn_cvt_pk_fp8_f32(c, d, w, true); return (unsigned)w; }
struct EpiP {
    static constexpr bool PERM = true, AFTER_DRAIN = false;
    unsigned char* P;
    __device__ __forceinline__ void operator()(const f32x4 (&acc)[2][2][4][2], const Unit& u, int wr, int wc, int fr, int fq) const {
        unsigned char* const P = launder_s(this->P);
        const int br = u.pn >> 2, row0 = (u.pm & 127) * 256 + wr * 64 + fr, col0 = (u.pn & 3) * 256 + wc * 32 + 8 * fq;
#pragma unroll
        for (int ai = 0; ai < 2; ++ai)
#pragma unroll
            for (int m = 0; m < 4; ++m)
#pragma unroll
                for (int bj = 0; bj < 2; ++bj) { v2u w; w.x = fp8x4(acc[ai][bj][m][0]); w.y = fp8x4(acc[ai][bj][m][1]); *(GAS v2u*)(P + p_index(br, row0 + ai * 128 + m * 16, col0 + bj * 128)) = w; }
    }
};
struct EpiGate {
    static constexpr bool PERM = false, AFTER_DRAIN = false;
    const unsigned char* P; bf16* merged;
    __device__ __forceinline__ void operator()(const f32x4 (&acc)[2][2][4][2], const Unit& u, int wr, int wc, int fr, int fq) const {
        const unsigned char* const P = launder_s(this->P); bf16* const merged = launder_s(this->merged);
        const int row0 = u.pm * 256 + wr * 64 + fr, cq = 64 * u.pn + 16 * wc + 4 * fq;
        unsigned pv[2][4][4];
#pragma unroll
        for (int ai = 0; ai < 2; ++ai)
#pragma unroll
            for (int m = 0; m < 4; ++m)
#pragma unroll
                for (int br = 0; br < 4; ++br) pv[ai][m][br] = *(const GAS unsigned*)(P + p_index(br, row0 + ai * 128 + m * 16, cq));
        __builtin_amdgcn_sched_barrier(0);
        f32x4 sg[2][2][4][2];
#pragma unroll
        for (int ai = 0; ai < 2; ++ai)
#pragma unroll
            for (int bj = 0; bj < 2; ++bj)
#pragma unroll
                for (int m = 0; m < 4; ++m)
#pragma unroll
                    for (int n = 0; n < 2; ++n) { const f32x4 g = acc[ai][bj][m][n]; sg[ai][bj][m][n] = (f32x4){frcp(1.0f + fexp2(g.x)), frcp(1.0f + fexp2(g.y)), frcp(1.0f + fexp2(g.z)), frcp(1.0f + fexp2(g.w))}; }
        __builtin_amdgcn_sched_barrier(0);
#pragma unroll
        for (int ai = 0; ai < 2; ++ai)
#pragma unroll
            for (int m = 0; m < 4; ++m) { const int row = row0 + ai * 128 + m * 16; f32x4 s = {0.f, 0.f, 0.f, 0.f};
#pragma unroll
                for (int bj = 0; bj < 2; ++bj)
#pragma unroll
                    for (int n = 0; n < 2; ++n) { const int p = (int)pv[ai][m][2 * bj + n]; const f32x4 g = sg[ai][bj][m][n];
                        const f32x2 lo = __builtin_amdgcn_cvt_pk_f32_fp8(p, false), hi = __builtin_amdgcn_cvt_pk_f32_fp8(p, true);
                        s.x += g.x * lo.x; s.y += g.y * lo.y; s.z += g.z * hi.x; s.w += g.w * hi.y; }
                v2u w; w.x = pk2(s.x, s.y); w.y = pk2(s.z, s.w); *(GAS v2u*)(merged + (size_t)row * 1024 + cq) = w; }
    }
};
struct EpiOut {
    static constexpr bool PERM = false, AFTER_DRAIN = false;
    const float* xin; float* xout;
    __device__ __forceinline__ void operator()(const f32x4 (&acc)[2][2][4][2], const Unit& u, int wr, int wc, int fr, int fq) const {
        const float* const xin = launder_s(this->xin); float* const xout = launder_s(this->xout);
        const int row0 = u.pm * 256 + wr * 64 + fr, col0 = u.pn * 256 + wc * 32 + 4 * fq;
#pragma unroll
        for (int ai = 0; ai < 2; ++ai) {
            f32x4 xv[4][2][2];
#pragma unroll
            for (int m = 0; m < 4; ++m)
#pragma unroll
                for (int bj = 0; bj < 2; ++bj)
#pragma unroll
                    for (int n = 0; n < 2; ++n) xv[m][bj][n] = *(const GAS f32x4*)(xin + (size_t)(row0 + ai * 128 + m * 16) * DM + col0 + bj * 128 + n * 16);
#pragma unroll
            for (int m = 0; m < 4; ++m)
#pragma unroll
                for (int bj = 0; bj < 2; ++bj)
#pragma unroll
                    for (int n = 0; n < 2; ++n) *(GAS f32x4*)(xout + (size_t)(row0 + ai * 128 + m * 16) * DM + col0 + bj * 128 + n * 16) = xv[m][bj][n] + acc[ai][bj][m][n];
        }
    }
};
struct EpiGU {
    static constexpr bool PERM = true, AFTER_DRAIN = false;
    const float* rw; bf16* hh;
    __device__ __forceinline__ void operator()(const f32x4 (&acc)[2][2][4][2], const Unit& u, int wr, int wc, int fr, int fq) const {
        const float* const rw = launder_s(this->rw); bf16* const hh = launder_s(this->hh);
        const int row0 = u.pm * 256 + wr * 64 + fr, f0 = 128 * (u.pn & 1) + wc * 32 + 8 * fq;
        const __amdgpu_buffer_rsrc_t hrs = __builtin_amdgcn_make_buffer_rsrc((void*)hh, 0, MOE_MAXROWS * 256 * 2, 0x00020000);
        float rwv[2][4];
#pragma unroll
        for (int ai = 0; ai < 2; ++ai)
#pragma unroll
            for (int m = 0; m < 4; ++m) rwv[ai][m] = *(const GAS float*)(rw + row0 + ai * 128 + m * 16);
        __builtin_amdgcn_sched_barrier(0);
        f32x4 su[2][4][2];
#pragma unroll
        for (int ai = 0; ai < 2; ++ai)
#pragma unroll
            for (int m = 0; m < 4; ++m)
#pragma unroll
                for (int n = 0; n < 2; ++n)
#pragma unroll
                    for (int e = 0; e < 4; ++e) { const float g = acc[ai][0][m][n][e]; su[ai][m][n][e] = g * sigmoidf_(g) * acc[ai][1][m][n][e]; }
        __builtin_amdgcn_sched_barrier(0);
#pragma unroll
        for (int ai = 0; ai < 2; ++ai)
#pragma unroll
            for (int m = 0; m < 4; ++m) { const int row = row0 + ai * 128 + m * 16; const float w = rwv[ai][m];
                __builtin_amdgcn_raw_buffer_store_b128(pack8(su[ai][m][0] * w, su[ai][m][1] * w), hrs, row * 512 + f0 * 2, 0, 16); }
    }
};
struct EpiDown {
    static constexpr bool PERM = true, AFTER_DRAIN = false;
    const int* rtok; unsigned char* y0; unsigned char* y1;
    __device__ __forceinline__ void operator()(const f32x4 (&acc)[2][2][4][2], const Unit& u, int wr, int wc, int fr, int fq) const {
        const int* const rtok = launder_s(this->rtok); unsigned char* const y0 = launder_s(this->y0); unsigned char* const y1 = launder_s(this->y1);
        const int row0 = u.pm * 256 + wr * 64 + fr, col0 = (u.pn & 3) * 256 + wc * 32 + 8 * fq;
        int tsv[2][4];
#pragma unroll
        for (int ai = 0; ai < 2; ++ai)
#pragma unroll
            for (int m = 0; m < 4; ++m) tsv[ai][m] = *(const GAS int*)(rtok + row0 + ai * 128 + m * 16);
        __builtin_amdgcn_sched_barrier(0);
        v2u wq[2][4][2];
#pragma unroll
        for (int ai = 0; ai < 2; ++ai)
#pragma unroll
            for (int m = 0; m < 4; ++m)
#pragma unroll
                for (int bj = 0; bj < 2; ++bj) { wq[ai][m][bj].x = fp8x4(acc[ai][bj][m][0] * Y_SCALE); wq[ai][m][bj].y = fp8x4(acc[ai][bj][m][1] * Y_SCALE); }
        __builtin_amdgcn_sched_barrier(0);
#pragma unroll
        for (int ai = 0; ai < 2; ++ai)
#pragma unroll
            for (int m = 0; m < 4; ++m) { const int ts = tsv[ai][m];
                if (ts >= 0) { unsigned char* rowp = ((ts & 1) ? y1 : y0) + (size_t)(ts >> 1) * DM + col0;
#pragma unroll
                    for (int bj = 0; bj < 2; ++bj) *(GAS v2u*)(rowp + bj * 128) = wq[ai][m][bj]; } }
    }
};
struct POrder {
    int G, c;
    __device__ bool next(int i, Unit& u) const { const int L = i * G + c; if (L >= 2048) return false; const int n = L >> 9, r = L & 511; u.pm = __builtin_amdgcn_readfirstlane(n * 128 + (r >> 2)); u.pn = __builtin_amdgcn_readfirstlane(n * 4 + (r & 3)); return true; }
    __device__ __forceinline__ unsigned a_peek(const Unit&) const { return 0u; }
    __device__ __forceinline__ void a_ready(const Unit&, unsigned = 0u) const {}
    __device__ __forceinline__ void done(const Unit&) const {}
};
struct Moe9Order {
    int G, c, ntile; const LAS int* tile_e; unsigned* tcnt;
    __device__ bool next(int i, Unit& u) const { const int L = i * G + c; if (L >= ntile * 2) return false; const int pm = L >> 1, j = L & 1; u.pm = __builtin_amdgcn_readfirstlane(pm); u.pn = __builtin_amdgcn_readfirstlane(tile_e[pm] * 2 + j); return true; }
    __device__ __forceinline__ unsigned a_peek(const Unit&) const { return 0u; }
    __device__ __forceinline__ void a_ready(const Unit&, unsigned = 0u) const {}
    __device__ __forceinline__ void done(const Unit& u) const {
        asm volatile("s_waitcnt vmcnt(0)" ::: "memory");
        if (lane_id_opaque() == 0) (void)__hip_atomic_fetch_add(tcnt + 64 * u.pm, 1u, __ATOMIC_RELAXED, __HIP_MEMORY_SCOPE_AGENT);
    }
};
struct Moe10Order {
    int G, cv, nl, ntile; const LAS int* tile_e; unsigned* tcnt; unsigned* tmo; int wave;
    __device__ bool next(int i, Unit& u) const { const int r = cv < nl ? i : i + 2; const int m = (r < 2 ? r * nl : 2 * nl + (r - 2) * G) + cv; if (m >= ntile * 4) return false;
        const int pm = m >> 2, j = m & 3; u.pm = __builtin_amdgcn_readfirstlane(pm); u.pn = __builtin_amdgcn_readfirstlane(tile_e[pm] * 4 + j); return true; }
    __device__ __forceinline__ unsigned a_peek(const Unit& u) const { return wave == 0 ? __hip_atomic_load(tcnt + 64 * u.pm, __ATOMIC_RELAXED, __HIP_MEMORY_SCOPE_AGENT) : 16u; }
    __device__ __forceinline__ void a_ready(const Unit& u, unsigned peek = 0u) const {
        if (wave == 0) {
            unsigned sp = 0u;
            if ((unsigned)__builtin_amdgcn_readfirstlane((int)peek) < 16u)
            while ((unsigned)__builtin_amdgcn_readfirstlane((int)__hip_atomic_load(tcnt + 64 * u.pm, __ATOMIC_RELAXED, __HIP_MEMORY_SCOPE_AGENT)) < 16u) {
                __builtin_amdgcn_s_sleep(2);
                if ((++sp & 255u) == 0u) { if (__builtin_amdgcn_readfirstlane((int)__hip_atomic_load(tmo, __ATOMIC_RELAXED, __HIP_MEMORY_SCOPE_AGENT)) != 0) break;
                    if (sp > (1u << 18)) { if (lane_id_opaque() == 0) __hip_atomic_store(tmo, 1u, __ATOMIC_RELAXED, __HIP_MEMORY_SCOPE_AGENT); break; } } }
            __builtin_amdgcn_fence(__ATOMIC_ACQUIRE, "agent");
            asm volatile("s_waitcnt vmcnt(0)" ::: "memory");
        }
        asm volatile("" ::: "memory"); __builtin_amdgcn_s_barrier(); asm volatile("" ::: "memory");
    }
    __device__ __forceinline__ void done(const Unit&) const {}
};

constexpr int TK_ROW = 1025;
constexpr int TK_STATE = 32 * TK_ROW * 4 + 64;
__device__ __forceinline__ unsigned fkey(float s) { const unsigned b = __builtin_bit_cast(unsigned, s); return b ^ ((unsigned)((int)b >> 31) | 0x80000000u); }
__device__ __forceinline__ float unkeyf(unsigned k) {
    if (k <= 0x007FFFFFu) return -__builtin_inff(); if (k >= 0xFF800000u) return __builtin_inff();
    return __builtin_bit_cast(float, (k & 0x80000000u) ? (k ^ 0x80000000u) : ~k);
}
__device__ __forceinline__ void lin_bin_range(int b, unsigned& klo, unsigned& width) {
    unsigned lo, hi; bool hi_max = false;
    if (b == 0) { lo = 0u; hi = fkey(-511.0f); }
    else if (b <= 511) { lo = fkey((float)(b - 512)); hi = (b == 511) ? 0x80000000u : fkey((float)(b - 511)); }
    else if (b == 512) { lo = 0x80000000u; hi = 0x80000001u; }
    else if (b <= 1022) { lo = fkey((float)(b - 513)) + 1u; hi = fkey((float)(b - 512)) + 1u; }
    else { lo = fkey(510.0f) + 1u; hi = 0u; hi_max = true; }
    klo = lo; width = hi_max ? (0u - lo) : (hi - lo);
}
__device__ __forceinline__ int tk_bin(float s) {
    const float c = __builtin_amdgcn_fmed3f(s, -512.0f, 511.0f);
    return 512 + (int)__builtin_copysignf(__builtin_ceilf(__builtin_fabsf(c)), c);
}
struct TkState { unsigned klo[32], width[32], shift[32], mode[32], r[32], T[32], I[32], cnt[32], smax[32], sexp[32], more[2], ovf; };
constexpr unsigned TK_CAP = 1024;

__device__ __forceinline__ void topk_subunit(const Frame& F0, int b, int qt) {
    const Frame F = phase_frame(F0);
    LAS unsigned* hist = (LAS unsigned*)F.lds;
    LAS TkState* st = (LAS TkState*)(F.lds + TK_STATE);
    const int lane = F.lane, wave = F.wave, q16 = lane & 15, g = lane >> 4;
    const int tok0 = b * SEQ + 32 * qt;
    const bf16* IQ = wsp<bf16>(F, PO_IQ); const bf16* IK = wsp<bf16>(F, PO_IK); const float* IW = wsp<float>(F, MI_IW);
    bf16x8 Bq[2][4]; float clo[2][4], chi[2][4];
#define TK_BUILD_BQ(fs_) { v4u raw_[2][4]; f32x4 iw_[2];   \
    _Pragma("unroll") for (int hf = 0; hf < 2; ++hf) { const int tok = tok0 + 16 * hf + q16; iw_[hf] = *(const GAS f32x4*)(IW + (size_t)tok * 4); \
        _Pragma("unroll") for (int h = 0; h < 4; ++h) raw_[hf][h] = *(const GAS v4u*)(IQ + (size_t)tok * 128 + h * 32 + 8 * g); } \
    __builtin_amdgcn_sched_barrier(0); \
    _Pragma("unroll") for (int hf = 0; hf < 2; ++hf) \
        _Pragma("unroll") for (int h = 0; h < 4; ++h) { const v4u raw = raw_[hf][h]; const float w = iw_[hf][h] * IDX_SCALE * fs_[hf]; \
            v4u o; o.x = pk2(bf_lo(raw.x) * w, bf_hi(raw.x) * w); o.y = pk2(bf_lo(raw.y) * w, bf_hi(raw.y) * w); o.z = pk2(bf_lo(raw.z) * w, bf_hi(raw.z) * w); o.w = pk2(bf_lo(raw.w) * w, bf_hi(raw.w) * w); \
            Bq[hf][h] = __builtin_bit_cast(bf16x8, o); clo[hf][h] = w > 0.f ? 0.f : -__builtin_inff(); chi[hf][h] = w > 0.f ? __builtin_inff() : 0.f; } }
    float fs[2] = {1.0f, 1.0f};
    if (F.tid < 32) { const int tq = 32 * qt + F.tid; const bool all = (tq + 1 <= TOPK_SEL);
        st->mode[F.tid] = all ? 0u : 3u; st->r[F.tid] = TOPK_SEL; st->T[F.tid] = 0u; st->I[F.tid] = 0xFFFFFFFFu; st->klo[F.tid] = 0u; st->width[F.tid] = 1u; st->shift[F.tid] = 0u; st->cnt[F.tid] = 0u; st->smax[F.tid] = 0u; }
    if (F.tid == 0) { st->more[0] = 0u; st->more[1] = 0u; st->ovf = 0u; }
#define TK_LST() ((GAS v2u*)wsp<v2u>(F, WS_DELTA) + (size_t)F.bid * (32u * TK_CAP))
    bool uselist = false;
    const int nkt = 2 * (qt + 1);
    const char* const ikB = (const char*)IK + (size_t)b * SEQ * 64; const unsigned offA = (unsigned)q16 * 64u + (unsigned)g * 16u;
    int lim[2];
#pragma unroll
    for (int hf = 0; hf < 2; ++hf) lim[hf] = 32 * qt + 16 * hf + q16 - 4 * g;
    LAS unsigned* const hrow0 = hist + q16 * TK_ROW; LAS unsigned* const hrow1 = hist + (16 + q16) * TK_ROW;
#define TK_SCORE(hf_) const f32x4 sc = idx_score(A, Bq[hf_], clo[hf_], chi[hf_]);
    for (int i = F.tid; i < 32 * TK_ROW / 4; i += NTHR) ((LAS v4u*)hist)[i] = (v4u){0u, 0u, 0u, 0u};
    v4u Ars[2];
#pragma unroll
    for (int tt = 0; tt < 2; ++tt) { const int kt = (wave + NWAVES * tt) * (nkt >= 16 ? nkt >> 4 : 1); Ars[tt] = *(const GAS v4u*)(ikB + (size_t)(kt < nkt ? kt : 0) * 1024 + offA); }
    __syncthreads();
#pragma unroll 1
    for (int rnd = 0; rnd < 2; ++rnd) {
        TK_BUILD_BQ(fs)
        if (rnd == 0) {
#pragma unroll
            for (int tt = 0; tt < 2; ++tt) { const int kt = (wave + NWAVES * tt) * (nkt >= 16 ? nkt >> 4 : 1);
                if (kt < nkt) { const bf16x8 A = __builtin_bit_cast(bf16x8, Ars[tt]);
#pragma unroll
                    for (int hf = 0; hf < 2; ++hf) { TK_SCORE(hf); const float m = __builtin_fmaxf(__builtin_fmaxf(__builtin_fabsf(sc[0]), __builtin_fabsf(sc[1])), __builtin_fmaxf(__builtin_fabsf(sc[2]), __builtin_fabsf(sc[3])));
                        __hip_atomic_fetch_max(&st->smax[16 * hf + q16], __builtin_bit_cast(unsigned, m), __ATOMIC_RELAXED, __HIP_MEMORY_SCOPE_WORKGROUP); } } }
            __syncthreads();
#pragma unroll
            for (int hf = 0; hf < 2; ++hf) { const int E = (int)(st->smax[16 * hf + q16] >> 23) - 127; const int e = E >= 8 ? 0 : (E <= 0 ? 8 : 8 - E);
                fs[hf] = __builtin_bit_cast(float, (unsigned)(127 + e) << 23); }
            if (F.tid < 32) { const int E = (int)(st->smax[F.tid] >> 23) - 127; st->sexp[F.tid] = (unsigned)(E >= 8 ? 0 : (E <= 0 ? 8 : 8 - E)); }
        }
    }
#undef TK_BUILD_BQ
    for (int pass = 0; pass < 12; ++pass) {
#define TK_LOAD(dst_, kt_) asm volatile("global_load_dwordx4 %0, %1, off" : "=&v"(dst_) : "v"(ikB + (size_t)(kt_) * 1024 + offA) : "memory")
#define TK_LANDED(a_, b_) asm volatile("s_waitcnt vmcnt(0)" : "+v"(a_), "+v"(b_))
        v4u A0b, A1b;
        if (!uselist) { TK_LOAD(A0b, wave); TK_LOAD(A1b, (wave + NWAVES < nkt ? wave + NWAVES : wave)); TK_LANDED(A0b, A1b); }
#define TK_TWO_TILES() \
                const int kt1 = kt + NWAVES; const bool has1 = kt1 < nkt; f32x4 sA[2], sB[2]; \
                v4u A0n, A1n; \
                { const int kn = kt + 2 * NWAVES; TK_LOAD(A0n, (kn < nkt ? kn : 0)); } \
                { const int kn = kt + 3 * NWAVES; TK_LOAD(A1n, (kn < nkt ? kn : 0)); } \
                { const bf16x8 A = __builtin_bit_cast(bf16x8, A0b); { TK_SCORE(0); sA[0] = sc; } { TK_SCORE(1); sA[1] = sc; } } \
                { const bf16x8 A = __builtin_bit_cast(bf16x8, A1b); { TK_SCORE(0); sB[0] = sc; } { TK_SCORE(1); sB[1] = sc; } }
#define TK_TILES_END() TK_LANDED(A0n, A1n); A0b = A0n; A1b = A1n;
        if (pass == 0) {
            const bool lin0 = st->mode[q16] == 3u, lin1 = st->mode[16 + q16] == 3u; const unsigned linv0 = lin0 ? 1u : 0u, linv1 = lin1 ? 1u : 0u;
            for (int kt = wave; kt < nkt; kt += 2 * NWAVES) {
                TK_TWO_TILES();
                if (kt1 < 2 * qt) {
#pragma unroll
                    for (int tt = 0; tt < 2; ++tt)
#pragma unroll
                        for (int hf = 0; hf < 2; ++hf) {
                            LAS unsigned* const hrow = hf ? hrow1 : hrow0; const unsigned val = hf ? linv1 : linv0;
#pragma unroll
                            for (int r = 0; r < 4; ++r) __hip_atomic_fetch_add(hrow + tk_bin(tt ? sB[hf][r] : sA[hf][r]), val, __ATOMIC_RELAXED, __HIP_MEMORY_SCOPE_WORKGROUP);
                        }
                } else {
#pragma unroll
                    for (int tt = 0; tt < 2; ++tt)
#pragma unroll
                        for (int hf = 0; hf < 2; ++hf) {
                            LAS unsigned* const hrow = hf ? hrow1 : hrow0; const bool lin = (hf ? lin1 : lin0) & (tt == 0 || has1); const int ktt = tt ? kt1 : kt;
#pragma unroll
                            for (int r = 0; r < 4; ++r) { const float s = tt ? sB[hf][r] : sA[hf][r];
                                const unsigned val = (lin & (16 * ktt <= lim[hf] - r)) ? 1u : 0u;
                                __hip_atomic_fetch_add(hrow + tk_bin(s), val, __ATOMIC_RELAXED, __HIP_MEMORY_SCOPE_WORKGROUP); }
                        }
                }
                TK_TILES_END();
            }
        } else if (!uselist) {
            unsigned qmode[2], qklo[2], qwidth[2], qshift[2]; float qlo[2], qhi[2];
#pragma unroll
            for (int hf = 0; hf < 2; ++hf) { const int q = 16 * hf + q16; qmode[hf] = st->mode[q]; qklo[hf] = st->klo[q]; qwidth[hf] = st->width[q]; qshift[hf] = st->shift[q];
                const bool act = (qmode[hf] == 1u || qmode[hf] == 2u);
                qlo[hf] = act ? unkeyf(qklo[hf]) : __builtin_inff(); qhi[hf] = act ? unkeyf(qklo[hf] + (qwidth[hf] - 1u)) : __builtin_inff(); }
            LDS_WAIT();
#define TK_HIT(hf_, d_, idx_) do { \
                if (qmode[hf_] == 1u) __hip_atomic_fetch_add(hrow + ((d_) >> qshift[hf_]), 1u, __ATOMIC_RELAXED, __HIP_MEMORY_SCOPE_WORKGROUP); \
                else __hip_atomic_fetch_add(hrow + ((idx_) >> 5), 1u << ((idx_) & 31), __ATOMIC_RELAXED, __HIP_MEMORY_SCOPE_WORKGROUP); \
                if (pass == 1) { const unsigned pos_ = __hip_atomic_fetch_add(&st->cnt[16 * (hf_) + q16], 1u, __ATOMIC_RELAXED, __HIP_MEMORY_SCOPE_WORKGROUP); \
                    TK_LST()[(size_t)(16 * (hf_) + q16) * TK_CAP + (pos_ < TK_CAP ? pos_ : TK_CAP - 1u)] = (v2u){(d_) + qklo[hf_], (unsigned)(idx_)}; } } while (0)
            for (int kt = wave; kt < nkt; kt += 2 * NWAVES) {
                TK_TWO_TILES();
                if (kt1 < 2 * qt) {
#pragma unroll
                    for (int tt = 0; tt < 2; ++tt)
#pragma unroll
                        for (int hf = 0; hf < 2; ++hf) {
                            LAS unsigned* const hrow = hf ? hrow1 : hrow0; const int ktt = tt ? kt1 : kt;
                            bool anyin = false;
#pragma unroll
                            for (int r = 0; r < 4; ++r) { const float s = tt ? sB[hf][r] : sA[hf][r]; anyin |= (__builtin_amdgcn_fmed3f(s, qlo[hf], qhi[hf]) == s); }
                            if (__builtin_expect(anyin, 0)) {
#pragma unroll
                                for (int r = 0; r < 4; ++r) { const float s = tt ? sB[hf][r] : sA[hf][r];
                                    if ((s >= qlo[hf]) & (s <= qhi[hf])) { const unsigned d = fkey(s) - qklo[hf]; const int idx = 16 * ktt + 4 * g + r;
                                        if (d < qwidth[hf]) TK_HIT(hf, d, idx); } } }
                        }
                } else
#pragma unroll
                for (int tt = 0; tt < 2; ++tt)
#pragma unroll
                    for (int hf = 0; hf < 2; ++hf) {
                        LAS unsigned* const hrow = hf ? hrow1 : hrow0; const int ktt = tt ? kt1 : kt; const bool ok = (tt == 0 || has1);
                        bool in[4], anyin = false;
#pragma unroll
                        for (int r = 0; r < 4; ++r) { const float s = tt ? sB[hf][r] : sA[hf][r]; in[r] = (s >= qlo[hf]) & (s <= qhi[hf]) & (16 * ktt <= lim[hf] - r) & ok; anyin |= in[r]; }
                        if (__builtin_expect(anyin, 0)) {
#pragma unroll
                            for (int r = 0; r < 4; ++r) if (in[r]) { const float s = tt ? sB[hf][r] : sA[hf][r]; const unsigned d = fkey(s) - qklo[hf]; const int idx = 16 * ktt + 4 * g + r;
                                if (d < qwidth[hf]) TK_HIT(hf, d, idx); } }
                    }
                TK_TILES_END();
            }
#undef TK_HIT
        } else {
#pragma unroll 1
            for (int qi = 0; qi < 4; ++qi) {
                const int q = 4 * wave + qi; const unsigned mode = st->mode[q]; if (mode != 1u && mode != 2u) continue;
                const unsigned klo = st->klo[q], width = st->width[q], sh = st->shift[q], n = st->cnt[q]; LAS unsigned* const hrow = hist + q * TK_ROW;
                for (unsigned e = (unsigned)lane; e < n; e += 64u) { const v2u ent = TK_LST()[(size_t)q * TK_CAP + e]; const unsigned d = ent.x - klo;
                    if (d < width) {
                        if (mode == 1u) __hip_atomic_fetch_add(hrow + (d >> sh), 1u, __ATOMIC_RELAXED, __HIP_MEMORY_SCOPE_WORKGROUP);
                        else __hip_atomic_fetch_add(hrow + (ent.y >> 5), 1u << (ent.y & 31), __ATOMIC_RELAXED, __HIP_MEMORY_SCOPE_WORKGROUP); } }
            }
        }
        __syncthreads();
#pragma unroll 1
        for (int qi = 0; qi < 4; ++qi) {
            const int q = 4 * wave + qi; const unsigned mode = st->mode[q]; if (mode == 0u) continue;
            const LAS unsigned* hrow = hist + q * TK_ROW; const unsigned rr = st->r[q];
            if (mode != 2u) {
                unsigned wv[16]; unsigned c = 0;
#pragma unroll
                for (int i = 0; i < 4; ++i) { const v4u t = *(const LAS v4u*)(hrow + 16 * lane + 4 * i); wv[4 * i] = t.x; wv[4 * i + 1] = t.y; wv[4 * i + 2] = t.z; wv[4 * i + 3] = t.w; }
#pragma unroll
                for (int i = 0; i < 16; ++i) c += wv[i];
                const unsigned pin = wave_prefix_incl_u(c), tot = (unsigned)__builtin_amdgcn_readlane((int)pin, 63);
                const unsigned above = tot - pin, incl = above + c;
                if (above < rr && rr <= incl) {
                    unsigned cum = above; int bsel = -1; unsigned csel = 0, rsel = 0;
#pragma unroll
                    for (int i = 15; i >= 0; --i) { if (bsel < 0 && cum + wv[i] >= rr) { bsel = 16 * lane + i; csel = wv[i]; rsel = rr - cum; } cum += wv[i]; }
                    unsigned klo, width;
                    if (mode == 3u) lin_bin_range(bsel, klo, width);
                    else { const unsigned sh = st->shift[q], ok = st->klo[q], ow = st->width[q]; const unsigned off = (unsigned)bsel << sh; klo = ok + off; const unsigned rem = ow - off, cap = 1u << sh; width = rem < cap ? rem : cap; }
                    if (csel == rsel) { st->mode[q] = 0u;
                        if (klo == 0x80000000u) { st->T[q] = klo; st->I[q] = 8191u; }
                        else { st->T[q] = klo ? klo - 1u : 0u; st->I[q] = 0xFFFFFFFFu; } }
                    else { st->klo[q] = klo; st->width[q] = width; st->r[q] = rsel;
                        if (width == 1u) st->mode[q] = 2u; else { st->mode[q] = 1u; const int nb = 32 - __builtin_clz(width - 1u); st->shift[q] = nb > 10 ? (unsigned)(nb - 10) : 0u; }
                        st->more[pass & 1] = 1u; }
                }
            } else {
                const v4u t = *(const LAS v4u*)(hrow + 4 * lane); const unsigned c = __builtin_popcount(t.x) + __builtin_popcount(t.y) + __builtin_popcount(t.z) + __builtin_popcount(t.w);
                const unsigned incl = wave_prefix_incl_u(c);
                const unsigned below = incl - c;
                if (below < rr && rr <= incl) {
                    unsigned need = rr - below; unsigned wsel = 0; int wi = 0; bool found = false;
                    const unsigned ws4[4] = {t.x, t.y, t.z, t.w};
#pragma unroll
                    for (int i = 0; i < 4; ++i) { const unsigned pc = __builtin_popcount(ws4[i]); if (!found) { if (need <= pc) { wsel = ws4[i]; wi = i; found = true; } else need -= pc; } }
                    unsigned m = wsel; for (unsigned k = 1; k < need; ++k) m &= m - 1u;
                    const int bit = __builtin_ctz(m);
                    st->mode[q] = 0u; st->T[q] = st->klo[q]; st->I[q] = (unsigned)((4 * lane + wi) * 32 + bit);
                }
            }
            if (pass == 1 && lane == 0 && st->mode[q] != 0u && st->cnt[q] > TK_CAP) st->ovf = 1u;
        }
        { LAS v4u* const wrow = (LAS v4u*)(hist + 4 * wave * TK_ROW);
          for (int i = lane; i < TK_ROW; i += 64) wrow[i] = (v4u){0u, 0u, 0u, 0u}; }
        __syncthreads();
        const unsigned more = st->more[pass & 1], ovf = st->ovf;
        if (F.tid == 0) st->more[(pass + 1) & 1] = 0u;
        if (!more) break;
        if (pass == 1) uselist = (ovf == 0u);
    }
#undef TK_SCORE
#undef TK_TWO_TILES
    if (F.tid < 32) { const unsigned T = st->T[F.tid]; float* thr = wsp<float>(F, MI_THR) + (size_t)(tok0 + F.tid) * 2;
        thr[0] = unkeyf(T) * __builtin_bit_cast(float, (127u - st->sexp[F.tid]) << 23); ((int*)thr)[1] = (int)st->I[F.tid]; }
}


constexpr int DS_KA = 0, DS_VT = 34816, DS_STAGE = 34816 + 40960, DS_MASK = 2 * DS_STAGE, DS_END = DS_MASK + 8192;
constexpr float DS_MARGIN = 16.0f, DS_BIG = 32768.0f;
static_assert(DS_END <= MISC_OFF, "DSA LDS map");
__device__ __forceinline__ void dsa_subunit(const Frame& F0, int b, int qt) {
    const Frame F = phase_frame(F0);
    const int lane = F.lane, wave = F.wave, q16 = lane & 15, g = lane >> 4, qg = wave & 3, hp = wave >> 2;
    LAS unsigned char* L = F.lds;
    const bf16* QA = wsp<bf16>(F, PO_QA); const bf16* KA = wsp<bf16>(F, PO_KA); const bf16* VT = wsp<bf16>(F, PO_VT);
    const bf16* IQ = wsp<bf16>(F, PO_IQ); const bf16* IK = wsp<bf16>(F, PO_IK); const float* IW = wsp<float>(F, MI_IW); const float* THR = wsp<float>(F, MI_THR);
    bf16* YA = wsp<bf16>(F, WS_Y);
    const int tq = 64 * qt + 16 * qg + q16, tok = b * SEQ + tq;
    bf16x8 Bq[4], Q[2][2]; float clo[4], chi[4];
    { const f32x4 iw = *(const GAS f32x4*)(IW + (size_t)tok * 4);
#pragma unroll
      for (int h = 0; h < 4; ++h) { const v4u raw = *(const GAS v4u*)(IQ + (size_t)tok * 128 + h * 32 + 8 * g); const float w = iw[h] * IDX_SCALE;
          v4u o; o.x = pk2(bf_lo(raw.x) * w, bf_hi(raw.x) * w); o.y = pk2(bf_lo(raw.y) * w, bf_hi(raw.y) * w); o.z = pk2(bf_lo(raw.z) * w, bf_hi(raw.z) * w); o.w = pk2(bf_lo(raw.w) * w, bf_hi(raw.w) * w);
          Bq[h] = __builtin_bit_cast(bf16x8, o); clo[h] = w > 0.f ? 0.f : -__builtin_inff(); chi[h] = w > 0.f ? __builtin_inff() : 0.f; }
#pragma unroll
      for (int hh = 0; hh < 2; ++hh)
#pragma unroll
          for (int ks = 0; ks < 2; ++ks) Q[hh][ks] = __builtin_bit_cast(bf16x8, *(const GAS v4u*)(QA + (size_t)tok * 256 + (2 * hp + hh) * 64 + ks * 32 + 8 * g)); }
    const float Tf = THR[(size_t)tok * 2]; const int Iraw = ((const int*)THR)[(size_t)tok * 2 + 1]; const int limQ = tq - 8 * g, limI = Iraw - 8 * g;
    const bool anytie = __builtin_amdgcn_ballot_w64(Iraw >= 0) != 0ull;
    f32x4 O[2][4]; float mref[2], lrun[2]; bool seen[2];
#pragma unroll
    for (int hh = 0; hh < 2; ++hh) { mref[hh] = 0.f; lrun[hh] = 0.f; seen[hh] = false;
#pragma unroll
        for (int dt = 0; dt < 4; ++dt) O[hh][dt] = (f32x4){0.f, 0.f, 0.f, 0.f}; }
    unsigned goff[10];
#pragma unroll
    for (int i = 0; i < 10; ++i) { const int p = wave + 8 * i;
        if (p < 34) { const int c = 64 * p + lane, row = c / 34, part = c % 34, s = row >> 5, tau = (row >> 4) & 1, ii = row & 15, key = 32 * s + 8 * (ii >> 2) + 4 * tau + (ii & 3);
            goff[i] = (unsigned)key * 512u + (unsigned)(part < 32 ? part : 31) * 16u; }
        else { const int c = 64 * (p - 34) + lane, row = c / 10, w = c % 10, s = w / 5, part = w % 5;
            goff[i] = (unsigned)row * (unsigned)(NTOK * 2) + (unsigned)(32 * s + 8 * (part < 4 ? part : 3)) * 2u; } }
    const char* const kaB0 = (const char*)KA + (size_t)b * SEQ * 512; const char* const vtB0 = (const char*)VT + (size_t)b * SEQ * 2;
#define DSA_DMA(it_, buf_) do { const char* kaB = kaB0 + (size_t)(it_) * (64 * 512); const char* vtB = vtB0 + (size_t)(it_) * 128; LAS unsigned char* Ls = L + (buf_) * DS_STAGE; \
        _Pragma("unroll") for (int i = 0; i < 10; ++i) { const int p = wave + 8 * i; \
            if (p < 34) __builtin_amdgcn_global_load_lds((const unsigned*)(kaB + goff[i]), (LAS unsigned*)(Ls + DS_KA + p * 1024), 16, 0, 0); \
            else if (p < 74) __builtin_amdgcn_global_load_lds((const unsigned*)(vtB + goff[i]), (LAS unsigned*)(Ls + DS_VT + (p - 34) * 1024), 16, 0, 0); } } while (0)
    const char* const ikB0 = (const char*)IK + ((size_t)b * SEQ + 32 * hp + 8 * (q16 >> 2) + (q16 & 3)) * 64 + g * 16;
#define DSA_IKLD(it_, d0_, d1_) do { const char* p_ = ikB0 + (size_t)(it_) * (64 * 64); d0_ = *(const GAS v4u*)(p_); d1_ = *(const GAS v4u*)(p_ + 4 * 64); } while (0)
#define DSA_MASK(it_, buf_, I0_, I1_) do { unsigned mw0 = 0u, mw1 = 0u; const int kb_ = 64 * (it_) + 32 * hp; \
        const f32x4 sc0_ = idx_score(__builtin_bit_cast(bf16x8, I0_), Bq, clo, chi), sc1_ = idx_score(__builtin_bit_cast(bf16x8, I1_), Bq, clo, chi); \
        if ((it_) < qt && !anytie) { \
            _Pragma("unroll") for (int r = 0; r < 4; ++r) { mw0 |= (sc0_[r] > Tf) ? 0u : (0xffu << (8 * r)); mw1 |= (sc1_[r] > Tf) ? 0u : (0xffu << (8 * r)); } \
        } else { \
            _Pragma("unroll") for (int tau = 0; tau < 2; ++tau) _Pragma("unroll") for (int r = 0; r < 4; ++r) { const float s = tau ? sc1_[r] : sc0_[r]; \
                const int e = kb_ + 4 * tau + r; const bool sel = (e <= limQ) & ((s > Tf) | ((s == Tf) & (e <= limI))); \
                const unsigned nb = sel ? 0u : (0xffu << (8 * r)); if (tau) mw1 |= nb; else mw0 |= nb; } } \
        v2u mw_; mw_.x = mw0; mw_.y = mw1; *(LAS v2u*)(L + DS_MASK + (((buf_) * 4 + qg) * 2 + hp) * 512 + lane * 8) = mw_; } while (0)
#ifndef DSA_NO_SDWA
#define DSA_BIAS(B_, dst_, m_) asm("v_lshlrev_b32_sdwa %0, 23, sext(%1) dst_sel:DWORD dst_unused:UNUSED_PAD src0_sel:DWORD src1_sel:BYTE_" #B_ : "=v"(dst_) : "v"(m_))
#else
#define DSA_BIAS(B_, dst_, m_) dst_ = __builtin_bit_cast(float, (unsigned)(((int)((m_) << (24 - 8 * (B_))) >> 31)) & 0xff800000u)
#endif
    v4u nk0 = (v4u){0u, 0u, 0u, 0u}, nk1 = (v4u){0u, 0u, 0u, 0u};
    { v4u i0, i1; DSA_IKLD(0, i0, i1); DSA_DMA(0, 0); if (hp == 1) DSA_IKLD(qt > 0 ? 1 : 0, nk0, nk1); DSA_MASK(0, 0, i0, i1); }
    VM_WAIT();
    __syncthreads();
    const LAS unsigned char* const kRow = L + DS_KA + q16 * 544 + g * 16;
    const LAS unsigned char* const vRow = L + DS_VT + q16 * 160 + g * 16;
#define DSA_KLD(dst, c_) do { const int hh_ = (c_) & 1, s_ = (c_) >> 1; _Pragma("unroll") for (int tau = 0; tau < 2; ++tau) _Pragma("unroll") for (int ks = 0; ks < 2; ++ks) \
        dst[tau][ks] = *(const LAS bf16x8*)(kRow + cur * DS_STAGE + (32 * s_ + 16 * tau) * 544 + (2 * hp + hh_) * 128 + ks * 64); } while (0)
    for (int it = 0; it <= qt; ++it) {
        const int cur = it & 1;
        if (it < qt) {
            if (hp == 1) DSA_MASK(it + 1, cur ^ 1, nk0, nk1);
            DSA_DMA(it + 1, cur ^ 1);
            { const int itn = hp == 1 ? (it + 2 <= qt ? it + 2 : qt) : it + 1; DSA_IKLD(itn, nk0, nk1); }
        }
        f32x4 bias[2][2]; bool anysel[2];
#pragma unroll
        for (int s = 0; s < 2; ++s) { const v2u mw = *(const LAS v2u*)(L + DS_MASK + ((cur * 4 + qg) * 2 + s) * 512 + lane * 8); const unsigned m0 = mw.x, m1 = mw.y; float b0, b1, b2, b3; anysel[s] = (m0 & m1) != 0xffffffffu;
            DSA_BIAS(0, b0, m0); DSA_BIAS(1, b1, m0); DSA_BIAS(2, b2, m0); DSA_BIAS(3, b3, m0); bias[s][0] = (f32x4){b0, b1, b2, b3};
            DSA_BIAS(0, b0, m1); DSA_BIAS(1, b1, m1); DSA_BIAS(2, b2, m1); DSA_BIAS(3, b3, m1); bias[s][1] = (f32x4){b0, b1, b2, b3}; }
        bf16x8 Kf[2][2];
        DSA_KLD(Kf, 0);
        const bf16x8 ONES = __builtin_bit_cast(bf16x8, (v4u){0x3f803f80u, 0x3f803f80u, 0x3f803f80u, 0x3f803f80u});
#pragma unroll
        for (int c = 0; c < 4; ++c) {
            const int hh = c & 1, s = c >> 1, h = 2 * hp + hh;
            f32x4 S[2];
#pragma unroll
            for (int tau = 0; tau < 2; ++tau) { const f32x4 ci = bias[s][tau] - mref[hh];
                S[tau] = __builtin_amdgcn_mfma_f32_16x16x32_bf16(Kf[tau][0], Q[hh][0], ci, 0, 0, 0);
                S[tau] = __builtin_amdgcn_mfma_f32_16x16x32_bf16(Kf[tau][1], Q[hh][1], S[tau], 0, 0, 0); }
            bf16x8 Vf[4], Kn[2][2];
#pragma unroll
            for (int dt = 0; dt < 4; ++dt) Vf[dt] = *(const LAS bf16x8*)(vRow + cur * DS_STAGE + (h * 64 + 16 * dt) * 160 + s * 80);
            if (c < 3) DSA_KLD(Kn, c + 1);
            float a[8];
#pragma unroll
            for (int r = 0; r < 4; ++r) { a[r] = S[0][r]; a[4 + r] = S[1][r]; }
            float p[8];
#pragma unroll
            for (int j = 0; j < 8; ++j) p[j] = fexp2(a[j]);
            v4u pw; pw.x = pk2(p[0], p[1]); pw.y = pk2(p[2], p[3]); pw.z = pk2(p[4], p[5]); pw.w = pk2(p[6], p[7]);
            bf16x8 P = __builtin_bit_cast(bf16x8, pw);
            f32x4 lst = __builtin_amdgcn_mfma_f32_16x16x32_bf16(ONES, P, (f32x4){0.f, 0.f, 0.f, 0.f}, 0, 0, 0);
            const bool trig = !(lst[0] <= DS_BIG) | (!seen[hh] & anysel[s]);
            if (__builtin_amdgcn_ballot_w64(trig) != 0ull) {
#pragma unroll
                for (int tau = 0; tau < 2; ++tau) { const f32x4 ci = bias[s][tau] - mref[hh];
                    S[tau] = __builtin_amdgcn_mfma_f32_16x16x32_bf16(Kf[tau][0], Q[hh][0], ci, 0, 0, 0);
                    S[tau] = __builtin_amdgcn_mfma_f32_16x16x32_bf16(Kf[tau][1], Q[hh][1], S[tau], 0, 0, 0); }
#pragma unroll
                for (int r = 0; r < 4; ++r) { a[r] = S[0][r]; a[4 + r] = S[1][r]; }
                const float mx = fmaxf(fmaxf(fmaxf(a[0], a[1]), fmaxf(a[2], a[3])), fmaxf(fmaxf(a[4], a[5]), fmaxf(a[6], a[7])));
                float rmx = fmaxf(mx, shx(mx, 16, lane)); rmx = fmaxf(rmx, shx(rmx, 32, lane));
                const bool any = rmx > -__builtin_inff();
                const float delta = seen[hh] ? fmaxf(rmx, 0.f) : (any ? rmx : 0.f);
                seen[hh] = seen[hh] | any; mref[hh] += delta; const float alpha = fexp2(-delta); lrun[hh] *= alpha;
#pragma unroll
                for (int dt = 0; dt < 4; ++dt) O[hh][dt] = O[hh][dt] * alpha;
#pragma unroll
                for (int j = 0; j < 8; ++j) p[j] = fexp2(a[j] - delta);
                pw.x = pk2(p[0], p[1]); pw.y = pk2(p[2], p[3]); pw.z = pk2(p[4], p[5]); pw.w = pk2(p[6], p[7]);
                P = __builtin_bit_cast(bf16x8, pw);
                lst = __builtin_amdgcn_mfma_f32_16x16x32_bf16(ONES, P, (f32x4){0.f, 0.f, 0.f, 0.f}, 0, 0, 0);
            }
            lrun[hh] += lst[0];
#pragma unroll
            for (int dt = 0; dt < 4; ++dt) O[hh][dt] = __builtin_amdgcn_mfma_f32_16x16x32_bf16(Vf[dt], P, O[hh][dt], 0, 0, 0);
            if (c < 3) {
#pragma unroll
                for (int tau = 0; tau < 2; ++tau) { Kf[tau][0] = Kn[tau][0]; Kf[tau][1] = Kn[tau][1]; } }
        }
        if (hp == 0 && it < qt) DSA_MASK(it + 1, cur ^ 1, nk0, nk1);
        VM_WAIT();
        __syncthreads();
    }
#undef DSA_DMA
#undef DSA_IKLD
#undef DSA_MASK
#undef DSA_BIAS
#undef DSA_KLD
#pragma unroll
    for (int hh = 0; hh < 2; ++hh) {
        const float inv = 1.0f / lrun[hh];
#pragma unroll
        for (int dt = 0; dt < 4; ++dt) { const f32x4 o = O[hh][dt] * inv; v2u w; w.x = pk2(o.x, o.y); w.y = pk2(o.z, o.w);
            *(GAS v2u*)(YA + (size_t)tok * 256 + (2 * hp + hh) * 64 + 16 * dt + 4 * g) = w; }
    }
    __syncthreads();
}

constexpr int SB_KC = 0, SB_VT = 16896, SB_STAGE = 16896 + 20480, SB_FLAGS = 2 * SB_STAGE;
constexpr float SB_EXIT = -110.0f, LN2 = 0.6931471805599453f;
__device__ __forceinline__ void sb_subunit(const Frame& F0, int b, int qt) {
    const Frame F = phase_frame(F0);
    const int tid = F.tid, lane = F.lane, wave = F.wave, q16 = lane & 15, g = lane >> 4, qg = wave & 3, hp = wave >> 2;
    LAS unsigned char* L = F.lds;
    const bf16* QC = wsp<bf16>(F, PO_QC); const bf16* KC = wsp<bf16>(F, PO_KC); const bf16* VT = wsp<bf16>(F, PO_VT) + (size_t)256 * NTOK;
    bf16* YC = wsp<bf16>(F, WS_Y) + (size_t)2 * NTOK * 256;
    LAS unsigned* flags = (LAS unsigned*)(L + SB_FLAGS);
    const int tq = 64 * qt + 16 * qg + q16, tok = b * SEQ + tq, tq_max = 64 * qt + 16 * qg + 15;
    bf16x8 Q[2][2];
#pragma unroll
    for (int hh = 0; hh < 2; ++hh)
#pragma unroll
        for (int ks = 0; ks < 2; ++ks) Q[hh][ks] = __builtin_bit_cast(bf16x8, *(const GAS v4u*)(QC + (size_t)tok * 256 + (2 * hp + hh) * 64 + ks * 32 + 8 * g));
    f32x4 O[2][4]; float Lrun[2] = {0.f, 0.f};
#pragma unroll
    for (int hh = 0; hh < 2; ++hh)
#pragma unroll
        for (int dt = 0; dt < 4; ++dt) O[hh][dt] = (f32x4){0.f, 0.f, 0.f, 0.f};
    v4u sK[2], sV[2];
    const size_t kbase = (size_t)b * SEQ;
#define SB_LOAD(kt_) do { const size_t k0 = kbase + 32 * (size_t)(kt_); \
        _Pragma("unroll") for (int i = 0; i < 2; ++i) { const int c = tid + 512 * i; sK[i] = *(const GAS v4u*)(KC + k0 * 256 + (size_t)c * 8); \
            sV[i] = *(const GAS v4u*)(VT + (size_t)(c >> 2) * NTOK + k0 + (c & 3) * 8); } } while (0)
#define SB_STORE(buf_) do { LAS unsigned char* Lb = L + (buf_) * SB_STAGE; \
        _Pragma("unroll") for (int i = 0; i < 2; ++i) { const int c = tid + 512 * i; *(LAS v4u*)(Lb + SB_KC + (c >> 5) * 528 + (c & 31) * 16) = sK[i]; \
            *(LAS v4u*)(Lb + SB_VT + (c >> 2) * 80 + (c & 3) * 16) = sV[i]; } } while (0)
    const int kt_top = 2 * qt + 1;
    SB_LOAD(kt_top); SB_STORE(0);
    __syncthreads();
    const int krow0 = 8 * (q16 >> 2) + (q16 & 3);
    for (int i = 0; i <= kt_top; ++i) {
        const int kt = kt_top - i; const LAS unsigned char* Lb = L + (i & 1) * SB_STAGE;
        if (kt > 0) SB_LOAD(kt - 1);
        if (32 * kt < tq_max) {
            float lbv[2][8], sufv[2][8], runv[2];
            LAS float* const xg = (LAS float*)(L + SB_FLAGS + 64) + ((wave * 2) * 16 + q16) * 4;
#pragma unroll
            for (int hh = 0; hh < 2; ++hh) {
                const int h = 2 * hp + hh;
                f32x4 S[2];
#pragma unroll
                for (int tau = 0; tau < 2; ++tau) { const LAS unsigned char* kp = Lb + SB_KC + (krow0 + 4 * tau) * 528 + h * 128 + g * 16;
                    S[tau] = __builtin_amdgcn_mfma_f32_16x16x32_bf16(*(const LAS bf16x8*)(kp), Q[hh][0], (f32x4){0.f, 0.f, 0.f, 0.f}, 0, 0, 0);
                    S[tau] = __builtin_amdgcn_mfma_f32_16x16x32_bf16(*(const LAS bf16x8*)(kp + 64), Q[hh][1], S[tau], 0, 0, 0); }
                float lk[8];
#pragma unroll
                for (int j = 0; j < 8; ++j) { const float z = j < 4 ? S[0][j] : S[1][j - 4]; const int idx = 32 * kt + 8 * g + j; const bool valid = idx < tq;
                    const float az = fabsf(z), e = fexp2(-az * LOG2E), sp = flog2(1.0f + e) * LN2;
                    const float k_ = -(fmaxf(z, 0.f) + sp);
                    lk[j] = valid ? k_ : 0.f; lbv[hh][j] = valid ? (k_ + z) : -__builtin_inff(); }
                float run = 0.f;
#pragma unroll
                for (int j = 7; j >= 0; --j) { sufv[hh][j] = run; run += lk[j]; }
                runv[hh] = run; xg[hh * 64 + g] = run;
            }
#pragma unroll
            for (int hh = 0; hh < 2; ++hh) {
                const int h = 2 * hp + hh;
                const f32x4 r4 = *(const LAS f32x4*)(xg + hh * 64);
                const float hi = (g < 1 ? r4.y : 0.f) + (g < 2 ? r4.z : 0.f) + (g < 3 ? r4.w : 0.f), tt = (r4.x + r4.y) + (r4.z + r4.w);
                const float base = Lrun[hh] + hi;
                float a[8];
#pragma unroll
                for (int j = 0; j < 8; ++j) a[j] = fexp2((lbv[hh][j] + base + sufv[hh][j]) * LOG2E);
                Lrun[hh] += tt;
                v4u pw; pw.x = pk2(a[0], a[1]); pw.y = pk2(a[2], a[3]); pw.z = pk2(a[4], a[5]); pw.w = pk2(a[6], a[7]);
                const bf16x8 P = __builtin_bit_cast(bf16x8, pw);
#pragma unroll
                for (int dt = 0; dt < 4; ++dt) { const bf16x8 V = *(const LAS bf16x8*)(Lb + SB_VT + (h * 64 + 16 * dt + q16) * 80 + g * 16);
                    O[hh][dt] = __builtin_amdgcn_mfma_f32_16x16x32_bf16(V, P, O[hh][dt], 0, 0, 0); }
            }
        }
        const bool act = (Lrun[0] >= SB_EXIT) || (Lrun[1] >= SB_EXIT);
        const unsigned long long bal = __ballot(act);
        if (lane == 0) flags[(i & 1) * 8 + wave] = (bal != 0ull) ? 1u : 0u;
        if (kt > 0) SB_STORE((i + 1) & 1);
        __syncthreads();
        unsigned any = 0;
#pragma unroll
        for (int w = 0; w < 8; ++w) any |= flags[(i & 1) * 8 + w];
        if (!any) break;
    }
#undef SB_LOAD
#undef SB_STORE
#pragma unroll
    for (int hh = 0; hh < 2; ++hh)
#pragma unroll
        for (int dt = 0; dt < 4; ++dt) { const f32x4 o = O[hh][dt]; v2u w; w.x = pk2(o.x, o.y); w.y = pk2(o.z, o.w);
            *(GAS v2u*)(YC + (size_t)tok * 256 + (2 * hp + hh) * 64 + 16 * dt + 4 * g) = w; }
    __syncthreads();
}

constexpr int SG_PITCH = 272;
__device__ __forceinline__ void sgu_unit(const Frame& F0, int layer, int chunk) {
    const Frame F = phase_frame(F0);
    const int lane = F.lane, wave = F.wave, q16 = lane & 15, g4 = lane >> 4;
    LAS unsigned char* L = F.lds;
    const bf16* GU = wsp<bf16>(F, PO_UB); const bf16* GV = wsp<bf16>(F, PO_VB); const bf16* WS = wsp<bf16>(F, WS_WS);
    bf16* YB = wsp<bf16>(F, WS_Y) + (size_t)1 * NTOK * 256;
    const int tok0 = chunk * 128;
    { const f32x4 lg = *(const f32x4*)(F.sgu_ln_g() + layer * 256 + 4 * lane), lbv = *(const f32x4*)(F.sgu_ln_b() + layer * 256 + 4 * lane);
      v2u rawv[16];
#pragma unroll
      for (int i = 0; i < 16; ++i) rawv[i] = *(const GAS v2u*)(GV + (size_t)(tok0 + 16 * wave + i) * 256 + 4 * lane);
#pragma unroll
      for (int i = 0; i < 16; ++i) { const int s = 16 * wave + i; const v2u raw = rawv[i];
          f32x4 v = {bf_lo(raw.x), bf_hi(raw.x), bf_lo(raw.y), bf_hi(raw.y)};
          const float mu = wave_sum((v.x + v.y) + (v.z + v.w), lane) * (1.0f / 256.0f); v = v - mu;
          const float var = wave_sum((v.x * v.x + v.y * v.y) + (v.z * v.z + v.w * v.w), lane) * (1.0f / 256.0f); const float rstd = 1.0f / sqrtf(var + EPS);
          const f32x4 o = v * rstd * lg + lbv;
          const unsigned p0 = pk2(o.x, o.y), p1 = pk2(o.z, o.w);
          *(LAS bf16*)(L + (4 * lane + 0) * SG_PITCH + 2 * s) = (bf16)(p0 & 0xffffu); *(LAS bf16*)(L + (4 * lane + 1) * SG_PITCH + 2 * s) = (bf16)(p0 >> 16);
          *(LAS bf16*)(L + (4 * lane + 2) * SG_PITCH + 2 * s) = (bf16)(p1 & 0xffffu); *(LAS bf16*)(L + (4 * lane + 3) * SG_PITCH + 2 * s) = (bf16)(p1 >> 16); } }
    __syncthreads();
    const int t0 = 16 * wave, nstep = (t0 + 15) / 32 + 1, tok = tok0 + t0 + q16;
    bf16x8 Bw[4][4]; v2u urv[4][4]; float bsv[4];
#pragma unroll
    for (int gI = 0; gI < 4; ++gI) {
#pragma unroll
        for (int j = 0; j < 4; ++j) Bw[gI][j] = __builtin_bit_cast(bf16x8, *(const GAS v4u*)(WS + ((size_t)gI * 128 + t0 + q16) * 128 + 32 * (j < nstep ? j : 0) + 8 * g4));
#pragma unroll
        for (int dt = 0; dt < 4; ++dt) urv[gI][dt] = *(const GAS v2u*)(GU + (size_t)tok * 256 + gI * 64 + 16 * dt + 4 * g4);
        bsv[gI] = F.b_spatial()[(layer * 4 + gI) * 128 + t0 + q16]; }
#pragma unroll
    for (int gI = 0; gI < 4; ++gI) {
        f32x4 acc[4];
#pragma unroll
        for (int dt = 0; dt < 4; ++dt) acc[dt] = (f32x4){0.f, 0.f, 0.f, 0.f};
#pragma unroll
        for (int j = 0; j < 4; ++j) if (j < nstep) {
#pragma unroll
            for (int dt = 0; dt < 4; ++dt) { const bf16x8 A = *(const LAS bf16x8*)(L + (gI * 64 + 16 * dt + q16) * SG_PITCH + (32 * j + 8 * g4) * 2);
                acc[dt] = __builtin_amdgcn_mfma_f32_16x16x32_bf16(A, Bw[gI][j], acc[dt], 0, 0, 0); }
        }
        const float bs = bsv[gI];
#pragma unroll
        for (int dt = 0; dt < 4; ++dt) { const int ch = gI * 64 + 16 * dt + 4 * g4; const v2u ur = urv[gI][dt];
            const f32x4 o = {bf_lo(ur.x) * (acc[dt].x + bs), bf_hi(ur.x) * (acc[dt].y + bs), bf_lo(ur.y) * (acc[dt].z + bs), bf_hi(ur.y) * (acc[dt].w + bs)};
            v2u w; w.x = pk2(o.x, o.y); w.y = pk2(o.z, o.w); *(GAS v2u*)(YB + (size_t)tok * 256 + ch) = w; }
    }
    __syncthreads();
}
__device__ __forceinline__ void conv_items(const Frame& F0, int layer) {
    const Frame F = phase_frame(F0);
    const bf16* BD = wsp<bf16>(F, PO_BD); const bf16* CD = wsp<bf16>(F, PO_CD); const bf16* XD = wsp<bf16>(F, PO_XD);
    bf16* YD = wsp<bf16>(F, WS_Y) + (size_t)3 * NTOK * 256;
    const float* cw = F.conv_w() + layer * 3 * 256;
    for (int it0 = F.bid * NTHR + F.tid; it0 < NTOK * 32; it0 += 2 * F.G * NTHR) {
        v4u cv[2][3], xv[2][3], bbv[2]; f32x4 wv[2][3][2];
#pragma unroll
        for (int u = 0; u < 2; ++u) { const int it = it0 + u * F.G * NTHR, tok = it >> 5, c0 = (it & 31) * 8, s = tok & (SEQ - 1);
            bbv[u] = *(const GAS v4u*)(BD + (size_t)tok * 256 + c0);
#pragma unroll
            for (int tap = 0; tap < 3; ++tap) { const int d = 2 - tap; const int tk = (s - d >= 0) ? tok - d : tok;
                cv[u][tap] = *(const GAS v4u*)(CD + (size_t)tk * 256 + c0); xv[u][tap] = *(const GAS v4u*)(XD + (size_t)tk * 256 + c0);
                wv[u][tap][0] = *(const GAS f32x4*)(cw + tap * 256 + c0); wv[u][tap][1] = *(const GAS f32x4*)(cw + tap * 256 + c0 + 4); } }
#pragma unroll
        for (int u = 0; u < 2; ++u) { const int it = it0 + u * F.G * NTHR, tok = it >> 5, c0 = (it & 31) * 8, s = tok & (SEQ - 1);
            float y[8];
#pragma unroll
            for (int e = 0; e < 8; ++e) y[e] = 0.f;
#pragma unroll
            for (int tap = 0; tap < 3; ++tap) { const int d = 2 - tap; const float on = (s - d >= 0) ? 1.0f : 0.0f; const v4u c = cv[u][tap], x = xv[u][tap];
                const f32x4 w0 = wv[u][tap][0] * on, w1 = wv[u][tap][1] * on;
                y[0] += w0.x * (bf_lo(c.x) * bf_lo(x.x)); y[1] += w0.y * (bf_hi(c.x) * bf_hi(x.x)); y[2] += w0.z * (bf_lo(c.y) * bf_lo(x.y)); y[3] += w0.w * (bf_hi(c.y) * bf_hi(x.y));
                y[4] += w1.x * (bf_lo(c.z) * bf_lo(x.z)); y[5] += w1.y * (bf_hi(c.z) * bf_hi(x.z)); y[6] += w1.z * (bf_lo(c.w) * bf_lo(x.w)); y[7] += w1.w * (bf_hi(c.w) * bf_hi(x.w)); }
            const v4u bb = bbv[u];
            v4u o; o.x = pk2(y[0] * bf_lo(bb.x), y[1] * bf_hi(bb.x)); o.y = pk2(y[2] * bf_lo(bb.y), y[3] * bf_hi(bb.y)); o.z = pk2(y[4] * bf_lo(bb.z), y[5] * bf_hi(bb.z)); o.w = pk2(y[6] * bf_lo(bb.w), y[7] * bf_hi(bb.w));
            *(GAS v4u*)(YD + (size_t)tok * 256 + c0) = o; }
    }
}

constexpr size_t MI_TILE = MI_CNT + 32 * 1024;
__device__ __forceinline__ void router_phase(const Frame& F0, int layer) {
    const Frame F = phase_frame(F0); const float* x = layer == 0 ? F.x_in() : F.out; const bf16* dl = wsp<bf16>(F, WS_DELTA);
    const int lane = F.lane, wave = F.wave, tid = F.tid;
    LAS float* wT = (LAS float*)F.lds;
    LAS unsigned* cnt = (LAS unsigned*)(F.lds + TAB_OFF);
    const float* w_re = F.w_re() + (size_t)layer * 1024 * 32; const float* w_rg = F.w_rg() + (size_t)layer * 1024 * 4;
    for (int k0 = wave * 64; k0 < 1024; k0 += 512) {
#pragma unroll 8
        for (int e = 0; e < 32; ++e) wT[e * 1024 + k0 + lane] = w_re[(size_t)(k0 + lane) * 32 + e]; }
    LAS float* bre = (LAS float*)(F.lds + TAB_OFF + 256);
    if (tid < 32) { cnt[tid] = 0u; bre[tid] = F.b_re()[layer * 32 + tid]; }
    f32x4 g2[4], wg[4][4];
#pragma unroll
    for (int j = 0; j < 4; ++j) { g2[j] = *(const f32x4*)(F.norm2_g() + layer * DM + 4 * lane + 256 * j);
#pragma unroll
        for (int e = 0; e < 4; ++e) wg[j][e] = *(const f32x4*)(w_rg + (size_t)(4 * lane + 256 * j + e) * 4); }
    const f32x4 brg = *(const f32x4*)(F.b_rg() + layer * 4);
    __syncthreads();
    int* EID = wsp<int>(F, MI_EID); float* EW = wsp<float>(F, MI_EW); bf16* H2 = wsp<bf16>(F, MO_H2);
    f32x4 vn[4], vm[4]; v2u dn[4], dm[4];
    { const size_t r0 = (size_t)(F.bid * 128 + wave * 16) * DM + 4 * lane;
#pragma unroll
      for (int j = 0; j < 4; ++j) { vn[j] = *(const GAS f32x4*)(x + r0 + 256 * j); dn[j] = *(const GAS v2u*)(dl + r0 + 256 * j); vm[j] = *(const GAS f32x4*)(x + r0 + DM + 256 * j); dm[j] = *(const GAS v2u*)(dl + r0 + DM + 256 * j); } }
    for (int i = 0; i < 16; ++i) {
        const int tok = F.bid * 128 + wave * 16 + i;
        f32x4 v[4]; float ss = 0.f;
#pragma unroll
        for (int j = 0; j < 4; ++j) { const v2u d = dn[j]; v[j] = vn[j] + (f32x4){bf_lo(d.x), bf_hi(d.x), bf_lo(d.y), bf_hi(d.y)};
            ss += (v[j].x * v[j].x + v[j].y * v[j].y) + (v[j].z * v[j].z + v[j].w * v[j].w); }
        { const size_t r2 = (size_t)(tok + (i < 14 ? 2 : 15 - i)) * DM + 4 * lane;
#pragma unroll
          for (int j = 0; j < 4; ++j) { vn[j] = vm[j]; dn[j] = dm[j]; vm[j] = *(const GAS f32x4*)(x + r2 + 256 * j); dm[j] = *(const GAS v2u*)(dl + r2 + 256 * j); } }
        const float rstd = 1.0f / sqrtf(wave_sum(ss, lane) * (1.0f / DM) + EPS);
#pragma unroll
        for (int j = 0; j < 4; ++j) { v[j] = v[j] * rstd * g2[j]; v2u w; w.x = pk2(v[j].x, v[j].y); w.y = pk2(v[j].z, v[j].w); *(GAS v2u*)(H2 + (size_t)tok * DM + 4 * lane + 256 * j) = w; }
        f32x4 gl = {0.f, 0.f, 0.f, 0.f};
#pragma unroll
        for (int j = 0; j < 4; ++j) { gl += wg[j][0] * v[j].x; gl += wg[j][1] * v[j].y; gl += wg[j][2] * v[j].z; gl += wg[j][3] * v[j].w; }
        gl.x = wave_sum(gl.x, lane) + brg.x; gl.y = wave_sum(gl.y, lane) + brg.y; gl.z = wave_sum(gl.z, lane) + brg.z; gl.w = wave_sum(gl.w, lane) + brg.w;
        int gs = 0; float gm = gl.x; if (gl.y > gm) { gm = gl.y; gs = 1; } if (gl.z > gm) { gm = gl.z; gs = 2; } if (gl.w > gm) { gm = gl.w; gs = 3; }
        const float grp_p = 1.0f / (__expf(gl.x - gm) + __expf(gl.y - gm) + __expf(gl.z - gm) + __expf(gl.w - gm));
        gs = __builtin_amdgcn_readfirstlane(gs);
        float el[8];
#pragma unroll
        for (int e = 0; e < 8; ++e) { const LAS float* wrow = wT + (gs * 8 + e) * 1024 + 4 * lane; float a = 0.f;
#pragma unroll
            for (int j = 0; j < 4; ++j) { const f32x4 w = *(const LAS f32x4*)(wrow + 256 * j); a += (w.x * v[j].x + w.y * v[j].y) + (w.z * v[j].z + w.w * v[j].w); }
            el[e] = wave_sum(a, lane) + bre[gs * 8 + e]; }
        int j1 = 0; float l1 = el[0];
#pragma unroll
        for (int e = 1; e < 8; ++e) if (el[e] > l1) { l1 = el[e]; j1 = e; }
        int j2 = -1; float l2 = -__builtin_inff();
#pragma unroll
        for (int e = 0; e < 8; ++e) if (e != j1 && el[e] > l2) { l2 = el[e]; j2 = e; }
        const float e2 = __expf(l2 - l1), w1 = grp_p / (1.0f + e2), w2 = grp_p * e2 / (1.0f + e2);
        if (lane == 0) { EID[tok * 2] = gs * 8 + j1; EID[tok * 2 + 1] = gs * 8 + j2; EW[tok * 2] = w1; EW[tok * 2 + 1] = w2;
            __hip_atomic_fetch_add(&cnt[gs * 8 + j1], 1u, __ATOMIC_RELAXED, __HIP_MEMORY_SCOPE_WORKGROUP); __hip_atomic_fetch_add(&cnt[gs * 8 + j2], 1u, __ATOMIC_RELAXED, __HIP_MEMORY_SCOPE_WORKGROUP); }
    }
    __syncthreads();
    if (tid < 32) wsp<int>(F, MI_CNT)[F.bid * 32 + tid] = (int)cnt[tid];
    __syncthreads();
}
__device__ __forceinline__ void gather_phase(const Frame& F0, int layer) {
    const Frame F = phase_frame(F0); const float* x = F.out;
    const int lane = F.lane, wave = F.wave, tid = F.tid;
    LAS int* part = (LAS int*)F.lds;
    LAS int* tot = part + 1024; LAS int* bef = tot + 32; LAS int* pst = bef + 32;
    LAS int* eidl = pst + 40; LAS int* posl = eidl + 256;
    const int* CNT = wsp<int>(F, MI_CNT);
    { const int e = tid & 31, p = tid >> 5; int st = 0, sb = 0;
      for (int w = p * 16; w < p * 16 + 16; ++w) { const int c = CNT[w * 32 + e]; st += c; sb += (w < F.bid) ? c : 0; }
      part[p * 32 + e] = st; part[512 + p * 32 + e] = sb; }
    if (tid < 256) eidl[tid] = wsp<int>(F, MI_EID)[F.bid * 256 + tid];
    __syncthreads();
    if (tid < 32) { int st = 0, sb = 0; for (int p = 0; p < 16; ++p) { st += part[p * 32 + tid]; sb += part[512 + p * 32 + tid]; } tot[tid] = st; bef[tid] = sb; }
    __syncthreads();
    if (tid == 0) { int a = 0; for (int e = 0; e < 32; ++e) { pst[e] = a; a += (tot[e] + 255) & ~255; } pst[32] = a; }
    __syncthreads();
    if (tid < 256) { const int e = eidl[tid]; int rank = 0; for (int i = 0; i < tid; ++i) rank += (eidl[i] == e) ? 1 : 0; posl[tid] = pst[e] + bef[e] + rank; }
    __syncthreads();
    int* RTOK = wsp<int>(F, MI_RTOK); float* RW = wsp<float>(F, MI_RW);
    const float* EW = wsp<float>(F, MI_EW);
    if (tid < 256) { const int p = posl[tid], tok = F.bid * 128 + (tid >> 1); RTOK[p] = tok * 2 + (tid & 1); RW[p] = EW[F.bid * 256 + tid]; }
    if (F.bid < 32) { const int e = F.bid; for (int r = pst[e] + tot[e] + tid; r < pst[e + 1]; r += NTHR) { RTOK[r] = -1; RW[r] = 0.f; } }
    if (F.bid == 32) { int* TILE = wsp<int>(F, MI_TILE); const int ntile = pst[32] >> 8;
        for (int pm = tid; pm < ntile; pm += NTHR) { int e = 0; for (int k = 1; k < 32; ++k) e += (pst[k] <= pm * 256) ? 1 : 0; TILE[pm] = e; }
        if (tid == 0) TILE[511] = ntile; }
    __syncthreads();
}

constexpr int PH_PER_LAYER = 11, PH_FINAL = DEPTH * PH_PER_LAYER, PH_TOTAL = PH_FINAL + 1;
struct Args { const void* in[20]; float* out; unsigned char* ws; int ph_lo, ph_hi, li, pad; };
__global__ void __launch_bounds__(NTHR, 2) hybrid_fwd(Args args) {
    extern __shared__ __attribute__((aligned(16))) unsigned char lds[];
    Frame F;
    F.lds = (LAS unsigned char*)lds; F.MISC = (volatile LAS unsigned*)(F.lds + MISC_OFF);
    F.wave = __builtin_amdgcn_readfirstlane((int)threadIdx.x >> 6); F.tid = 0; F.lane = 0; F.G = gridDim.x; F.bid = blockIdx.x;
    F.ws = args.ws; F.out = args.out; F.kin = (const CAS4 inptr_t*)__builtin_amdgcn_kernarg_segment_ptr();
    { const Frame FL = phase_frame(F); for (int u = FL.tid; u < 64; u += NTHR) ((LAS unsigned*)(F.lds + MISC_OFF))[u] = 0u; }
    __syncthreads();
    const int lo = args.ph_lo, hi = args.ph_hi;
    const bool use_bar = (hi - lo) > 1;
    unsigned* const barw = (unsigned*)(F.ws + WS_CTL) + CW_BAR + args.li * XCD_BAR_WORDS;
    XcdBarrier bar; bar.bar = barw; bar.x = 0; bar.st = nullptr;
    bar.wid = F.wave;
    if (use_bar) bar = xcd_barrier_post(barw, F.MISC + 8, F.wave);
#ifndef PH_MASK
#define PH_MASK 0xffffffu
#endif
#define INC(c, k) (((PH_MASK >> (c)) & 1u) && lo <= (k) && (k) < hi)
#ifndef PROBE_DUP
#define PROBE_DUP -1
#endif
#define DUPB(c) if (PROBE_DUP == (c) && layer == 0) xcd_barrier(bar)
#define SEAM(k) do { if (lo <= (k) && (k) + 1 < hi) xcd_barrier(bar); } while (0)
    PG8_LAS unsigned char* ring = (PG8_LAS unsigned char*)lds;
    const int cx = (F.bid & 7) * (F.G >> 3) + (F.bid >> 3);

#pragma unroll 1
    for (int layer = 0; layer < DEPTH; ++layer) {
        const int pb = layer * PH_PER_LAYER;
        if (INC(0, pb + 0)) {
            l0_weights(F, layer);
            if (layer == 0) { l0_rope(F); rms_rows<0, false>(F, 0); }
            else rms_rows<1, false>(F, layer);
#if PROBE_DUP == 0
            if (layer == 0) { xcd_barrier(bar); l0_weights(F, layer); l0_rope(F); rms_rows<0, false>(F, 0); }
#endif
        }
        SEAM(pb + 0);
        if (INC(1, pb + 1)) {
            {
            Frame FL = F; FL.ws = launder_s(F.ws);
            { pg8::Gemm g{wsp<bf16>(FL, WS_H), wsp<bf16>(FL, WS_WP), NTOK, 2560, 1024}; pg8::StaticOrder S; S.init(NTOK, 2560, F.G, F.bid); EpiProj E{FL.ws};
              pg8::gemm_phase<EpiProj, pg8::StaticOrder, true, true>(ring, g, S, E, F.wave); }
            FL.ws = launder_s(F.ws);
            { pg8::Gemm g{wsp<bf16>(FL, WS_WV), wsp<bf16>(FL, WS_H), 512, NTOK, 1024}; pg8::StaticOrder S; S.init(512, NTOK, F.G, F.bid); EpiStoreBf16 E{wsp<bf16>(FL, PO_VT), NTOK, 0x7fffffff};
              pg8::gemm_phase<EpiStoreBf16, pg8::StaticOrder, true, true>(ring, g, S, E, F.wave); }
            }
#if PROBE_DUP == 1
            if (layer == 0) { xcd_barrier(bar);
            Frame FL = F; FL.ws = launder_s(F.ws);
            { pg8::Gemm g{wsp<bf16>(FL, WS_H), wsp<bf16>(FL, WS_WP), NTOK, 2560, 1024}; pg8::StaticOrder S; S.init(NTOK, 2560, F.G, F.bid); EpiProj E{FL.ws};
              pg8::gemm_phase<EpiProj, pg8::StaticOrder, true, true>(ring, g, S, E, F.wave); }
            FL.ws = launder_s(F.ws);
            { pg8::Gemm g{wsp<bf16>(FL, WS_WV), wsp<bf16>(FL, WS_H), 512, NTOK, 1024}; pg8::StaticOrder S; S.init(512, NTOK, F.G, F.bid); EpiStoreBf16 E{wsp<bf16>(FL, PO_VT), NTOK, 0x7fffffff};
              pg8::gemm_phase<EpiStoreBf16, pg8::StaticOrder, true, true>(ring, g, S, E, F.wave); }
            }
#endif
        }
        SEAM(pb + 1);
        if (INC(2, pb + 2)) {
            for (int p0 = F.bid; p0 < 256; p0 += F.G) { const int p = ((p0 & 7) << 5) | (p0 >> 3), b = p >> 6, j = p & 63;
_Pragma("unroll 1") for (int k = 0; k < 4; ++k) { const int k2 = k >> 1; topk_subunit(F, b, (k & 1) ? 255 - 2 * j - k2 : 2 * j + k2); } }
#if PROBE_DUP == 2
            if (layer == 0) { xcd_barrier(bar); for (int p0 = F.bid; p0 < 256; p0 += F.G) { const int p = ((p0 & 7) << 5) | (p0 >> 3), b = p >> 6, j = p & 63;
_Pragma("unroll 1") for (int k = 0; k < 4; ++k) { const int k2 = k >> 1; topk_subunit(F, b, (k & 1) ? 255 - 2 * j - k2 : 2 * j + k2); } } }
#endif
        }
        if (lo <= pb + 2 && pb + 3 < hi) { VM_WAIT(); __syncthreads(); __builtin_amdgcn_fence(__ATOMIC_ACQUIRE, "agent"); VM_WAIT(); __syncthreads(); }
        if (INC(3, pb + 3)) {
            for (int u = F.bid; u < 512; u += F.G) sb_subunit(F, u >> 7, u & 127);
            for (int u = F.bid; u < 256; u += F.G) sgu_unit(F, layer, u);
            conv_items(F, layer);
#if PROBE_DUP == 12
            if (layer == 0) { xcd_barrier(bar); for (int u = F.bid; u < 512; u += F.G) sb_subunit(F, u >> 7, u & 127);
                for (int u = F.bid; u < 256; u += F.G) sgu_unit(F, layer, u);
                conv_items(F, layer); }
#endif
            for (int p0 = F.bid; p0 < 256; p0 += F.G) { const int p = ((p0 & 7) << 5) | (p0 >> 3), b = p >> 6, j = p & 63; dsa_subunit(F, b, j); dsa_subunit(F, b, 127 - j); }
#if PROBE_DUP == 3
            if (layer == 0) { xcd_barrier(bar); for (int p0 = F.bid; p0 < 256; p0 += F.G) { const int p = ((p0 & 7) << 5) | (p0 >> 3), b = p >> 6, j = p & 63; dsa_subunit(F, b, j); dsa_subunit(F, b, 127 - j); }     }
#endif
        }
        SEAM(pb + 3);
        if (INC(4, pb + 4)) { { Frame FL = F; FL.ws = launder_s(F.ws); pg8::Gemm g{wsp<bf16>(FL, WS_Y), wsp<bf16>(FL, WS_WB), 4 * NTOK, 4096, 256}; POrder S{F.G, cx}; EpiP E{wsp<unsigned char>(FL, WS_BIG)};
            pg8::gemm_phase<EpiP, POrder, true, true>(ring, g, S, E, F.wave); }
#if PROBE_DUP == 4
            if (layer == 0) { xcd_barrier(bar); { Frame FL = F; FL.ws = launder_s(F.ws); pg8::Gemm g{wsp<bf16>(FL, WS_Y), wsp<bf16>(FL, WS_WB), 4 * NTOK, 4096, 256}; POrder S{F.G, cx}; EpiP E{wsp<unsigned char>(FL, WS_BIG)};
            pg8::gemm_phase<EpiP, POrder, true, true>(ring, g, S, E, F.wave); } }
#endif
        }
        SEAM(pb + 4);
        if (INC(5, pb + 5)) { { Frame FL = F; FL.ws = launder_s(F.ws); pg8::Gemm g{wsp<bf16>(FL, WS_H), wsp<bf16>(FL, WS_WG), NTOK, 4096, 1024}; pg8::StaticOrder S; S.init(NTOK, 4096, F.G, F.bid); EpiGate E{wsp<unsigned char>(FL, WS_BIG), wsp<bf16>(FL, WS_Y)};
            pg8::gemm_phase<EpiGate, pg8::StaticOrder, true, true>(ring, g, S, E, F.wave); }
#if PROBE_DUP == 5
            if (layer == 0) { xcd_barrier(bar); { Frame FL = F; FL.ws = launder_s(F.ws); pg8::Gemm g{wsp<bf16>(FL, WS_H), wsp<bf16>(FL, WS_WG), NTOK, 4096, 1024}; pg8::StaticOrder S; S.init(NTOK, 4096, F.G, F.bid); EpiGate E{wsp<unsigned char>(FL, WS_BIG), wsp<bf16>(FL, WS_Y)};
            pg8::gemm_phase<EpiGate, pg8::StaticOrder, true, true>(ring, g, S, E, F.wave); } }
#endif
        }
        SEAM(pb + 5);
        if (INC(6, pb + 6)) { { Frame FL = F; FL.ws = launder_s(F.ws); pg8::Gemm g{wsp<bf16>(FL, WS_Y), wsp<bf16>(FL, WS_WO), NTOK, 1024, 1024}; pg8::StaticOrder S; S.init(NTOK, 1024, F.G, F.bid); EpiStoreBf16 E{wsp<bf16>(FL, WS_DELTA), 1024, 0x7fffffff};
            pg8::gemm_phase<EpiStoreBf16, pg8::StaticOrder, true, true>(ring, g, S, E, F.wave); }
#if PROBE_DUP == 6
            if (layer == 0) { xcd_barrier(bar); { Frame FL = F; FL.ws = launder_s(F.ws); pg8::Gemm g{wsp<bf16>(FL, WS_Y), wsp<bf16>(FL, WS_WO), NTOK, 1024, 1024}; pg8::StaticOrder S; S.init(NTOK, 1024, F.G, F.bid); EpiStoreBf16 E{wsp<bf16>(FL, WS_DELTA), 1024, 0x7fffffff};
            pg8::gemm_phase<EpiStoreBf16, pg8::StaticOrder, true, true>(ring, g, S, E, F.wave); } }
#endif
        }
        SEAM(pb + 6);
        if (INC(7, pb + 7)) { router_phase(F, layer);
#if PROBE_DUP == 7
            if (layer == 0) { xcd_barrier(bar); router_phase(F, layer); }
#endif
        }
        SEAM(pb + 7);
        if (INC(8, pb + 8)) { gather_phase(F, layer);
#if PROBE_DUP == 8
            if (layer == 0) { xcd_barrier(bar); gather_phase(F, layer); }
#endif
        }
        SEAM(pb + 8);
        if (INC(9, pb + 9) || INC(10, pb + 10)) {
            LAS int* tile_e = (LAS int*)(F.lds + TAB_OFF); const int* TILE = wsp<int>(F, MI_TILE); const int ntile = __builtin_amdgcn_readfirstlane(TILE[511]);
            LAS int* rowtab = (LAS int*)(F.lds + TAB_OFF + 4096);
            { const Frame FT = phase_frame(F); for (int i = FT.tid; i < ntile; i += NTHR) tile_e[i] = TILE[i];
              const int* RTOK = wsp<int>(FT, MI_RTOK);
              for (int q = FT.tid; q < 4 * 256; q += NTHR) { const int L = (q >> 8) * F.G + cx; int v = 0; if (L < ntile * 2) { const int r = RTOK[(L >> 1) * 256 + (q & 255)]; v = r < 0 ? 0 : (r >> 1); } rowtab[q] = v; } }
            __syncthreads();
            unsigned* const tcnt = (unsigned*)(F.ws + WS_CTL) + CW_TCNT + layer * TCNT_LAYER; unsigned* const tmo10 = (unsigned*)(F.ws + WS_CTL) + CW_TMO;
            const int r9 = (2 * ntile) % F.G, nl10 = F.G - r9, cv10 = cx >= r9 ? cx - r9 : nl10 + cx;
            if (INC(9, pb + 9)) { { Frame FL = F; FL.ws = launder_s(F.ws); pg8::Gemm g{wsp<bf16>(FL, MO_H2), wsp<bf16>(FL, WS_WGU), NTOK, 512 * NEXP, 1024}; Moe9Order S{F.G, cx, ntile, tile_e, tcnt}; EpiGU E{wsp<float>(FL, MI_RW), wsp<bf16>(FL, MO_HH)};
                pg8::gemm_phase<EpiGU, Moe9Order, true, true, true>(ring, g, S, E, F.wave, (const PG8_LAS int*)rowtab); }
#if PROBE_DUP == 9
            if (layer == 0) { xcd_barrier(bar); { Frame FL = F; FL.ws = launder_s(F.ws); pg8::Gemm g{wsp<bf16>(FL, MO_H2), wsp<bf16>(FL, WS_WGU), NTOK, 512 * NEXP, 1024}; Moe9Order S{F.G, cx, ntile, tile_e, tcnt}; EpiGU E{wsp<float>(FL, MI_RW), wsp<bf16>(FL, MO_HH)};
                pg8::gemm_phase<EpiGU, Moe9Order, true, true, true>(ring, g, S, E, F.wave, (const PG8_LAS int*)rowtab); } }
#endif
        }
            if (INC(10, pb + 10)) { { Frame FL = F; FL.ws = launder_s(F.ws); pg8::Gemm g{wsp<bf16>(FL, MO_HH), wsp<bf16>(FL, WS_WD), MOE_MAXROWS, 1024 * NEXP, 256}; Moe10Order S{F.G, cv10, nl10, ntile, tile_e, tcnt, tmo10, F.wave}; EpiDown E{wsp<int>(FL, MI_RTOK), wsp<unsigned char>(FL, MO_Y0), wsp<unsigned char>(FL, MO_Y1)};
                pg8::gemm_phase<EpiDown, Moe10Order, true, true>(ring, g, S, E, F.wave); }
#if PROBE_DUP == 10
            if (layer == 0) { xcd_barrier(bar); { Frame FL = F; FL.ws = launder_s(F.ws); pg8::Gemm g{wsp<bf16>(FL, MO_HH), wsp<bf16>(FL, WS_WD), MOE_MAXROWS, 1024 * NEXP, 256}; Moe10Order S{F.G, cv10, nl10, ntile, tile_e, tcnt, tmo10, F.wave}; EpiDown E{wsp<int>(FL, MI_RTOK), wsp<unsigned char>(FL, MO_Y0), wsp<unsigned char>(FL, MO_Y1)};
                pg8::gemm_phase<EpiDown, Moe10Order, true, true>(ring, g, S, E, F.wave); } }
#endif
        }
        }
        SEAM(pb + 10);
    }
    if (INC(11, PH_FINAL)) rms_rows<1, true>(F, 0);
#undef INC
#undef SEAM
}

#ifndef N_CUTS
#define N_CUTS 0
#endif
#ifndef PROBE_SPLIT
#define PROBE_SPLIT -1
#endif
extern "C" void kernel_launch(void* const* d_in, const int* in_sizes, int n_in, void* d_out, int out_size, void* d_ws, size_t ws_size, hipStream_t stream) {
    static int grid = 0;
    if (grid == 0) {
        if (n_in != 20 || out_size != NTOK * DM || ws_size < WS_END) { fprintf(stderr, "kernel_launch: unexpected shapes (n_in %d out %d ws %zu)\n", n_in, out_size, ws_size); grid = -1; return; }
        int dev = 0, cus = 0, per_cu = 0;
        if (hipGetDevice(&dev) != hipSuccess || hipDeviceGetAttribute(&cus, hipDeviceAttributeMultiprocessorCount, dev) != hipSuccess) { grid = -1; return; }
        if (hipFuncSetAttribute((const void*)hybrid_fwd, hipFuncAttributeMaxDynamicSharedMemorySize, LDS_BYTES) != hipSuccess) { fprintf(stderr, "kernel_launch: hipFuncSetAttribute failed\n"); grid = -1; return; }
        if (hipOccupancyMaxActiveBlocksPerMultiprocessor(&per_cu, (const void*)hybrid_fwd, NTHR, LDS_BYTES) != hipSuccess || per_cu < 1) fprintf(stderr, "kernel_launch: occupancy query reports %d\n", per_cu);
        (void)hipGetLastError();
        grid = cus;
        if (grid != 256) { fprintf(stderr, "kernel_launch: built for 256 CUs, found %d\n", cus); grid = -1; return; }
    }
    if (grid < 0) return;
    if (hipMemsetAsync((char*)d_ws + WS_CTL, 0, CTL_ZERO_BYTES, stream) != hipSuccess) return;
    Args a{};
    for (int i = 0; i < 20; ++i) a.in[i] = d_in[i];
    a.out = (float*)d_out; a.ws = (unsigned char*)d_ws;
#if N_CUTS == 0 && PROBE_SPLIT < 0
    a.ph_lo = 0; a.ph_hi = PH_TOTAL; a.li = 0;
    hipLaunchKernelGGL(hybrid_fwd, dim3(grid), dim3(NTHR), LDS_BYTES, stream, a);
#elif N_CUTS == 0
    a.ph_lo = 0; a.ph_hi = PROBE_SPLIT + 1; a.li = 0; hipLaunchKernelGGL(hybrid_fwd, dim3(grid), dim3(NTHR), LDS_BYTES, stream, a);
    a.ph_lo = PROBE_SPLIT; a.ph_hi = PH_TOTAL; a.li = 1; hipLaunchKernelGGL(hybrid_fwd, dim3(grid), dim3(NTHR), LDS_BYTES, stream, a);
#else
    for (int p = 0; p < PH_TOTAL; ++p) { a.ph_lo = p; a.ph_hi = p + 1; a.li = 0; hipLaunchKernelGGL(hybrid_fwd, dim3(grid), dim3(NTHR), LDS_BYTES, stream, a); }
#endif
}
```
